# Optimizing an MI355X kernel written in HIP

```python
import math
import jax, jax.numpy as jnp
from jax import lax
import numpy as np

D_MODEL = 1024
BATCH = 4
SEQ = 4096
DEPTH = 2

HEAD_DIM = 64
A_Q_HEADS = 8
A_KV_HEADS = 2
WINDOW = 128
B_HEADS = 8
WIN_ROWS = 8
WIN_COLS = 16
QCOLS = 16
KCOLS = QCOLS + WIN_COLS
C_Q_HEADS = 8
C_KV_HEADS = 2

A_Q = A_Q_HEADS * HEAD_DIM
A_KV = A_KV_HEADS * HEAD_DIM
B_W = B_HEADS * HEAD_DIM
C_Q = C_Q_HEADS * HEAD_DIM
C_KV = C_KV_HEADS * HEAD_DIM
BRANCH_WIDTH = A_Q
N_BRANCH = 3
IN_SIZES = (A_Q, A_KV, A_KV, B_W, B_W, B_W, C_Q, C_KV, C_KV, N_BRANCH * D_MODEL)
N_IN = A_Q + 2 * A_KV + 3 * B_W + C_Q + 2 * C_KV + N_BRANCH * D_MODEL

D_FF = 2816
META = 16
BLOCK = 128
PAD_FRONT = BLOCK - META
GRID_W = 64
ROPE_THETA = 10000.0
EPS = 1e-6
NEG = -1e30

kernel_name = "hybrid_gated_window_neighbourhood_axial_encoder"


def rms_norm(x, g):
    xf = x.astype(jnp.float32)
    y = xf * lax.rsqrt(jnp.mean(xf * xf, axis=-1, keepdims=True) + EPS)
    return (y * g.astype(jnp.float32)).astype(x.dtype)


def swiglu(h, w_in, w_out):
    gate, up = jnp.split(h @ w_in, 2, axis=-1)
    return (jax.nn.silu(gate) * up) @ w_out


def rope_angles(pos, dim):
    inv_freq = ROPE_THETA ** (-jnp.arange(0, dim, 2, dtype=jnp.float32) / dim)
    return pos.astype(jnp.float32)[:, None] * inv_freq[None, :]


def apply_rope(x, ang):
    half = x.shape[-1] // 2
    cos = jnp.cos(ang)[None, :, None, :]
    sin = jnp.sin(ang)[None, :, None, :]
    xf = x.astype(jnp.float32)
    x1, x2 = xf[..., :half], xf[..., half:]
    return jnp.concatenate([x1 * cos - x2 * sin, x2 * cos + x1 * sin], axis=-1).astype(x.dtype)


def apply_axial_rope(x, row, col):
    half = x.shape[-1] // 2
    xr = apply_rope(x[..., :half], rope_angles(row, half))
    xc = apply_rope(x[..., half:], rope_angles(col, half))
    return jnp.concatenate([xr, xc], axis=-1)


def window_sink_attention(q, k, v, sink):
    B, L, Hq, dh = q.shape
    Hkv = k.shape[2]
    G = Hq // Hkv
    Lp = L + PAD_FRONT
    nb = Lp // BLOCK
    scale = dh ** -0.5
    qb = jnp.pad(q, ((0, 0), (PAD_FRONT, 0), (0, 0), (0, 0))).reshape(B, nb, BLOCK, Hkv, G, dh)
    kv_pad = ((0, 0), (PAD_FRONT + BLOCK, BLOCK), (0, 0), (0, 0))
    kp = jnp.pad(k, kv_pad).reshape(B, nb + 2, BLOCK, Hkv, dh)
    vp = jnp.pad(v, kv_pad).reshape(B, nb + 2, BLOCK, Hkv, dh)
    kb = jnp.concatenate([kp[:, :-2], kp[:, 1:-1], kp[:, 2:]], axis=2)
    vb = jnp.concatenate([vp[:, :-2], vp[:, 1:-1], vp[:, 2:]], axis=2)
    q_pos = np.arange(nb)[:, None] * BLOCK + np.arange(BLOCK)[None, :]
    k_pos = (np.arange(nb)[:, None] - 1) * BLOCK + np.arange(3 * BLOCK)[None, :]
    kpb = k_pos[:, None, :]
    band = (np.abs(q_pos[:, :, None] - kpb) <= WINDOW) & (kpb >= PAD_FRONT + META) & (kpb < Lp)
    s_win = jnp.einsum('bnqhgd,bnkhd->bnhgqk', qb, kb).astype(jnp.float32) * scale
    s_win = jnp.where(band[None, :, None, None], s_win, NEG)
    km, vm = k[:, :META], v[:, :META]
    s_meta = jnp.einsum('bnqhgd,bmhd->bnhgqm', qb, km).astype(jnp.float32) * scale
    s = jnp.concatenate([s_meta, s_win], axis=-1)
    sk = sink.astype(jnp.float32).reshape(Hkv, G)[None, None, :, :, None, None]
    m = jnp.maximum(jnp.max(s, axis=-1, keepdims=True), sk)
    p = jnp.exp(s - m)
    p = (p / (jnp.sum(p, axis=-1, keepdims=True) + jnp.exp(sk - m))).astype(v.dtype)
    o = (jnp.einsum('bnhgqm,bmhd->bnqhgd', p[..., :META], vm)
         + jnp.einsum('bnhgqk,bnkhd->bnqhgd', p[..., META:], vb))
    return o.reshape(B, Lp, Hq * dh)[:, PAD_FRONT:]


def neighbourhood_attention(q, k, v, rpb):
    B, L, H, dh = q.shape
    S = L - META
    rows = S // GRID_W
    kr = min(WIN_ROWS, rows)
    ncb = GRID_W // QCOLS
    scale = dh ** -0.5
    qm, km, vm = q[:, :META], k[:, :META], v[:, :META]
    qg = q[:, META:].reshape(B, rows, ncb, QCOLS, H, dh)
    kt, vt = k[:, META:], v[:, META:]
    r = np.arange(rows)
    key_rows = np.clip(r - kr // 2, 0, rows - kr)[:, None] + np.arange(kr)[None, :]
    qcol = np.arange(ncb)[:, None] * QCOLS + np.arange(QCOLS)[None, :]
    qcol_start = np.clip(qcol - WIN_COLS // 2, 0, GRID_W - WIN_COLS)
    key_cols = (np.clip(np.arange(ncb) * QCOLS - WIN_COLS // 2, 0, GRID_W - KCOLS)[:, None]
                + np.arange(KCOLS)[None, :])
    tok = (key_rows[:, None, :, None] * GRID_W + key_cols[None, :, None, :]).reshape(rows, ncb, kr * KCOLS)
    kg = kt[:, tok]
    vg = vt[:, tok]
    col_ok = ((key_cols[:, None, :] >= qcol_start[:, :, None])
              & (key_cols[:, None, :] < qcol_start[:, :, None] + WIN_COLS))
    col_ok = np.broadcast_to(col_ok[:, :, None, :], (ncb, QCOLS, kr, KCOLS)).reshape(ncb, QCOLS, kr * KCOLS)
    dr = key_rows - r[:, None] + WIN_ROWS - 1
    dc = np.clip(key_cols[:, None, :] - qcol[:, :, None] + WIN_COLS - 1, 0, 2 * WIN_COLS - 2)
    bias = rpb[:, dr[:, None, None, :, None], dc[None, :, :, None, :]]
    bias = bias.reshape(H, rows, ncb, QCOLS, kr * KCOLS).astype(jnp.float32)
    s_win = jnp.einsum('brcqhd,brckhd->bhrcqk', qg, kg).astype(jnp.float32) * scale + bias[None]
    s_win = jnp.where(col_ok[None, None, None], s_win, NEG)
    s_meta = jnp.einsum('brcqhd,bmhd->bhrcqm', qg, km).astype(jnp.float32) * scale
    p = jax.nn.softmax(jnp.concatenate([s_meta, s_win], axis=-1), axis=-1).astype(v.dtype)
    og = (jnp.einsum('bhrcqm,bmhd->brcqhd', p[..., :META], vm)
          + jnp.einsum('bhrcqk,brckhd->brcqhd', p[..., META:], vg)).reshape(B, S, H * dh)
    sm = jnp.einsum('bmhd,bnhd->bhmn', qm, km).astype(jnp.float32) * scale
    om = jnp.einsum('bhmn,bnhd->bmhd', jax.nn.softmax(sm, axis=-1).astype(v.dtype), vm).reshape(B, META, H * dh)
    return jnp.concatenate([om, og], axis=1)


def dense_block_attention(q, k, v):
    B, L, Hq, dh = q.shape
    Hkv = k.shape[2]
    G = Hq // Hkv
    Lp = L + PAD_FRONT
    nb = Lp // BLOCK
    scale = dh ** -0.5
    pad = ((0, 0), (PAD_FRONT, 0), (0, 0), (0, 0))
    qb = jnp.pad(q, pad).reshape(B, nb, BLOCK, Hkv, G, dh)
    kp = jnp.pad(k, pad)
    vp = jnp.pad(v, pad)
    key_ok = np.arange(Lp) >= PAD_FRONT

    def one_block(qblk):
        s = jnp.einsum('bqhgd,bkhd->bhgqk', qblk, kp).astype(jnp.float32) * scale
        s = jnp.where(key_ok, s, NEG)
        p = jax.nn.softmax(s, axis=-1).astype(vp.dtype)
        return jnp.einsum('bhgqk,bkhd->bqhgd', p, vp)

    o = lax.map(one_block, jnp.moveaxis(qb, 1, 0))
    return jnp.moveaxis(o, 0, 1).reshape(B, Lp, Hq * dh)[:, PAD_FRONT:]


def hybrid_mixer(n, w_in, sink, rpb, qn, kn, w_branch, w_out, pos, row, col):
    B, L, _ = n.shape
    offsets = np.cumsum(IN_SIZES)[:-1].tolist()
    qa, ka, va, qb, kb, vb, qc, kc, vc, gates = jnp.split(n @ w_in, offsets, axis=-1)
    heads = lambda t, h: t.reshape(B, L, h, HEAD_DIM)
    ang = rope_angles(pos, HEAD_DIM)
    oa = window_sink_attention(apply_rope(heads(qa, A_Q_HEADS), ang), apply_rope(heads(ka, A_KV_HEADS), ang),
                               heads(va, A_KV_HEADS), sink)
    ob = neighbourhood_attention(heads(qb, B_HEADS), heads(kb, B_HEADS), heads(vb, B_HEADS), rpb)
    qc = apply_axial_rope(rms_norm(heads(qc, C_Q_HEADS), qn), row, col)
    kc = apply_axial_rope(rms_norm(heads(kc, C_KV_HEADS), kn), row, col)
    oc = dense_block_attention(qc, kc, heads(vc, C_KV_HEADS))
    branches = jnp.stack([oa, ob, oc], axis=2)
    up = jnp.einsum('blnc,ncd->blnd', branches, w_branch)
    g = jax.nn.sigmoid(gates.reshape(B, L, N_BRANCH, D_MODEL))
    return jnp.sum(g * up, axis=2) @ w_out


def setup_inputs(seed: int = 0) -> dict:
    key = jax.random.key(seed)
    ks = jax.random.split(key, 17)
    f32 = jnp.float32

    def nrm(k, shape, scale):
        return jax.random.normal(k, shape, f32) * scale

    def gain(k, shape):
        return 1.0 + 0.02 * jax.random.normal(k, shape, f32)

    return {
        "x": nrm(ks[0], (BATCH, SEQ, D_MODEL), 1.0),
        "meta_tokens": nrm(ks[1], (META, D_MODEL), 1.0),
        "ffn1_norm": gain(ks[2], (DEPTH, D_MODEL)),
        "ffn1_w_in": nrm(ks[3], (DEPTH, D_MODEL, 2 * D_FF), D_MODEL ** -0.5),
        "ffn1_w_out": nrm(ks[4], (DEPTH, D_FF, D_MODEL), D_FF ** -0.5),
        "mix_norm": gain(ks[5], (DEPTH, D_MODEL)),
        "w_in": nrm(ks[6], (DEPTH, D_MODEL, N_IN), D_MODEL ** -0.5),
        "sink_a": nrm(ks[7], (DEPTH, A_Q_HEADS), 0.5),
        "rpb_b": nrm(ks[8], (DEPTH, B_HEADS, 2 * WIN_ROWS - 1, 2 * WIN_COLS - 1), 0.1),
        "qnorm_c": gain(ks[9], (DEPTH, HEAD_DIM)),
        "knorm_c": gain(ks[10], (DEPTH, HEAD_DIM)),
        "w_branch": nrm(ks[11], (DEPTH, N_BRANCH, BRANCH_WIDTH, D_MODEL), BRANCH_WIDTH ** -0.5),
        "w_out": nrm(ks[12], (DEPTH, D_MODEL, D_MODEL), D_MODEL ** -0.5),
        "ffn2_norm": gain(ks[13], (DEPTH, D_MODEL)),
        "ffn2_w_in": nrm(ks[14], (DEPTH, D_MODEL, 2 * D_FF), D_MODEL ** -0.5),
        "ffn2_w_out": nrm(ks[15], (DEPTH, D_FF, D_MODEL), D_FF ** -0.5),
        "final_norm": gain(ks[16], (D_MODEL,)),
    }


def reference(x, meta_tokens, ffn1_norm, ffn1_w_in, ffn1_w_out, mix_norm, w_in, sink_a, rpb_b,
              qnorm_c, knorm_c, w_branch, w_out, ffn2_norm, ffn2_w_in, ffn2_w_out, final_norm):
    B, S, D = x.shape
    L = S + META
    h = jnp.concatenate([jnp.broadcast_to(meta_tokens.astype(x.dtype)[None], (B, META, D)), x], axis=1)
    p = np.arange(L)
    t = p - META
    pos = jnp.asarray(p)
    row = jnp.asarray(np.where(t >= 0, t // GRID_W, -1))
    col = jnp.asarray(np.where(t >= 0, t % GRID_W, p))
    for l in range(DEPTH):
        h = h + 0.5 * swiglu(rms_norm(h, ffn1_norm[l]), ffn1_w_in[l], ffn1_w_out[l])
        h = h + hybrid_mixer(rms_norm(h, mix_norm[l]), w_in[l], sink_a[l], rpb_b[l], qnorm_c[l], knorm_c[l],
                             w_branch[l], w_out[l], pos, row, col)
        h = h + 0.5 * swiglu(rms_norm(h, ffn2_norm[l]), ffn2_w_in[l], ffn2_w_out[l])
    return rms_norm(h, final_norm)[:, META:]
```

```cpp
#include <hip/hip_runtime.h>
#include <hip/hip_cooperative_groups.h>
#include <cstdio>
#include <cstdint>
namespace cg = cooperative_groups;

#define LAS __attribute__((address_space(3)))
#define GAS __attribute__((address_space(1)))
typedef unsigned short bf16_t;
typedef short bf16x8 __attribute__((ext_vector_type(8)));
typedef float f32x2 __attribute__((ext_vector_type(2)));
typedef float f32x4 __attribute__((ext_vector_type(4)));
typedef float f32x16 __attribute__((ext_vector_type(16)));
typedef unsigned u32x2 __attribute__((ext_vector_type(2)));
typedef unsigned u32x4 __attribute__((ext_vector_type(4)));
typedef __bf16 bf16x2_t __attribute__((ext_vector_type(2)));

constexpr int DM = 1024, NB = 4, SEQ = 4096, NMETA = 16, DFF = 2816, NIN = 6144, DEPTH = 2;
constexpr int NREAL = NB * SEQ;
constexpr int MROW0 = NREAL;
constexpr int NROWS = NREAL + NB * NMETA;
constexpr int QKP = 2304;
constexpr int QA_OFF = 0, KA_OFF = 512, QB_OFF = 640, KB_OFF = 1152, QC_OFF = 1664, KC_OFF = 2176;
constexpr int VL = SEQ + 32;
constexpr int NVH = 12;
constexpr float QS = 0.125f * 1.4426950408889634f;
constexpr float LOG2E = 1.4426950408889634f;
constexpr float EPS = 1e-6f;

constexpr size_t WS_CTL = 0;
constexpr size_t WS_BAR = 4096;
constexpr size_t CTL_BYTES = 32768;
constexpr size_t WS_HMETA = CTL_BYTES;
constexpr size_t WS_SSQ = WS_HMETA + 64 * 1024 * 4;
constexpr size_t WS_TAB = WS_SSQ + (size_t)16 * NROWS * 4;
constexpr size_t TAB_BYTES = 2 * 4112 * 32 * 4 + (65 + 65 + 64 + 64) * 16 * 4;
constexpr size_t WS_W = (WS_TAB + TAB_BYTES + 255) / 256 * 256;
constexpr size_t W_FO = 0, W_FIA = 4 * 5767168, W_FIB = W_FIA + 11534336, W_MI = W_FIB + 11534336, W_MB = W_MI + 12582912, W_MO = W_MB + 3145728;
constexpr size_t W_BYTES = W_MO + 2097152;
constexpr size_t WS_N = WS_W + W_BYTES;
constexpr size_t N_BYTES = (size_t)NROWS * 1024 * 2;
constexpr size_t WS_X = WS_N + N_BYTES;
constexpr size_t X_BYTES = (size_t)NROWS * 2816 * 2;
constexpr size_t WS_G = WS_X + X_BYTES;
constexpr size_t G_BYTES = (size_t)NROWS * 3072;
constexpr size_t WS_V = WS_G + G_BYTES;
constexpr size_t V_BYTES = (size_t)NB * NVH * 64 * VL * 2;
constexpr size_t WS_END = WS_V + V_BYTES + 256;

constexpr int LDS_BYTES = 131072 + 256;

struct Params {
    const float* x; const float* meta; const float* ffn1_norm; const float* ffn1_w_in; const float* ffn1_w_out;
    const float* mix_norm; const float* w_in; const float* sink; const float* rpb; const float* qn; const float* kn;
    const float* w_branch; const float* w_out; const float* ffn2_norm; const float* ffn2_w_in; const float* ffn2_w_out; const float* final_norm;
    float* out; unsigned char* ws;
};

__device__ __forceinline__ unsigned pk2(float lo, float hi) { f32x2 v = {lo, hi}; bf16x2_t b = __builtin_convertvector(v, bf16x2_t); return __builtin_bit_cast(unsigned, b); }
__device__ __forceinline__ float bflo(unsigned u) { return __uint_as_float(u << 16); }
__device__ __forceinline__ float bfhi(unsigned u) { return __uint_as_float(u & 0xffff0000u); }
__device__ __forceinline__ float shx(float v, int o, int lane) { return __builtin_bit_cast(float, __builtin_amdgcn_ds_bpermute((lane ^ o) << 2, __builtin_bit_cast(int, v))); }
__device__ __forceinline__ float wave_sum(float v, int lane) {
#pragma unroll
    for (int o = 1; o < 64; o <<= 1) v += shx(v, o, lane);
    return v;
}
__device__ __forceinline__ unsigned xb_ld(unsigned* p)              { return __hip_atomic_load(p, __ATOMIC_RELAXED, __HIP_MEMORY_SCOPE_AGENT); }
__device__ __forceinline__ unsigned xb_add(unsigned* p, unsigned v) { return __hip_atomic_fetch_add(p, v, __ATOMIC_RELAXED, __HIP_MEMORY_SCOPE_AGENT); }
__device__ __forceinline__ int ltid() { int t = threadIdx.x; asm volatile("" : "+v"(t)); return t; }
__device__ __forceinline__ float row_rstd(const float* ssqp, int row) {
    const f32x4* p = (const f32x4*)(ssqp + (size_t)row * 16); const f32x4 a = p[0], b = p[1], c = p[2], d = p[3];
    const float t = ((a.x + a.y) + (a.z + a.w)) + ((b.x + b.y) + (b.z + b.w)) + (((c.x + c.y) + (c.z + c.w)) + ((d.x + d.y) + (d.z + d.w)));
    return rsqrtf(t * (1.f / DM) + EPS);
}
__device__ __forceinline__ float* hrow(float* out, float* hmeta, int r) { return r < NREAL ? out + (size_t)r * DM : hmeta + (size_t)(r - NREAL) * DM; }

namespace pg8 {
#define PG8_LAS __attribute__((address_space(3)))
constexpr int BM = 256, BK = 64, HALF = 128, HTB = HALF * BK * 2, STAGE_BYTES = 8 * HTB, NXCD = 8, WGM = 8;
__host__ __device__ __forceinline__ int lds_byte(int r, int c) { const int st = (r >> 4) * 2 + (c >> 5), rr = r & 15, cc = c & 31, ob = rr * 64 + cc * 2; return st * 1024 + (ob ^ (((ob >> 9) & 1) << 5)); }
__host__ __device__ __forceinline__ void stage_rc(int b, int& R, int& C) { const int st = b / 1024, sb = b % 1024, swz = sb ^ (((sb >> 9) & 1) << 5); R = (st >> 1) * 16 + swz / 64; C = (st & 1) * 32 + (swz % 64) / 2; }
struct Unit { int pm, pn, b; const char* A; const char* B; };
struct Gemm { const bf16_t* A; const bf16_t* Bt; int M, N, K; };
struct StaticOrder {
    int nM, nN, nwg, G, c; const char* A; const char* Bt; size_t tstep;
    __device__ void init(int M, int N, int G_, int c_, const bf16_t* A_, const bf16_t* Bt_, int K) { nM = M / BM; nN = N / BM; nwg = nM * nN; G = G_; c = c_; A = (const char*)A_; Bt = (const char*)Bt_; tstep = (size_t)BM * K * 2; }
    __device__ void tile(int wgid, Unit& u) const {
        { const int q = nwg / NXCD, r = nwg % NXCD, xcd = wgid % NXCD, off = wgid / NXCD; wgid = (xcd < r ? xcd * (q + 1) : r * (q + 1) + (xcd - r) * q) + off; }
        const int nig = WGM * nN, gid = wgid / nig, fm = gid * WGM, gsz = (nM - fm) < WGM ? (nM - fm) : WGM;
        u.pm = fm + ((wgid % nig) % gsz); u.pn = (wgid % nig) / gsz;
    }
    __device__ bool next(int i, Unit& u) const {
        const long L = (long)i * G + c; if (L >= nwg) return false;
        tile((int)L, u); u.b = 0; u.A = A + (size_t)u.pm * tstep; u.B = Bt + (size_t)u.pn * tstep; return true;
    }
};
struct BranchOrder {
    StaticOrder base; const char* A3[3]; const char* B3[3];
    __device__ bool next(int i, Unit& u) const {
        if (i >= 3 || base.c >= base.nwg) return false;
        base.tile(base.c, u); u.b = i; u.A = (i == 0 ? A3[0] : i == 1 ? A3[1] : A3[2]) + (size_t)u.pm * base.tstep; u.B = (i == 0 ? B3[0] : i == 1 ? B3[1] : B3[2]) + (size_t)u.pn * base.tstep; return true;
    }
};

template <class Epi, class Sched, bool ALIGN_EPI = false, bool SP2 = false>
__device__ __forceinline__ void gemm_phase(PG8_LAS unsigned char* lds, const Gemm g, const Sched& S, const Epi& E) {
    int tid_ = threadIdx.x; asm volatile("" : "+v"(tid_)); const int tid = tid_, wid = __builtin_amdgcn_readfirstlane(tid >> 6), lane = tid & 63, wr = wid >> 2, wc = wid & 3, fr = lane & 15, fq = lane >> 4;
    const int K = g.K, nt = K / BK;
    unsigned voffA[2];
#pragma unroll
    for (int i = 0; i < 2; ++i) { int R, C; stage_rc(tid * 16 + i * 8192, R, C); voffA[i] = (unsigned)(R * K + C) * 2u; }
    const size_t kstep = (size_t)(BK * 2);
    const size_t hstep = (size_t)HALF * K * 2;
    const unsigned ldsw = (unsigned)wid * 1024u;
    const int aoff = lds_byte(wr * 64 + fr, fq * 8), boff = lds_byte(wc * 32 + fr, fq * 8);
#define PG8_SA(b, h) (((b) * 2 + (h)) * HTB)
#define PG8_SB(b, h) ((4 + (b) * 2 + (h)) * HTB)
#define PG8_STAGE(bufoff, gbase, voff) do { _Pragma("unroll") for (int _i = 0; _i < 2; ++_i) \
        __builtin_amdgcn_global_load_lds((const unsigned*)((const char*)(gbase) + (voff)[_i]), (PG8_LAS unsigned*)(lds + (bufoff) + ldsw + _i * 8192), 16, 0, 0); } while (0)
#define PG8_LDA(dst, b, h) do { _Pragma("unroll") for (int m = 0; m < 4; ++m) _Pragma("unroll") for (int k = 0; k < 2; ++k) dst[m][k] = *(const PG8_LAS bf16x8*)(lds + PG8_SA(b, h) + aoff + m * 2048 + k * 1024); } while (0)
#define PG8_LDB(dst, b, h) do { _Pragma("unroll") for (int n = 0; n < 2; ++n) _Pragma("unroll") for (int k = 0; k < 2; ++k) dst[n][k] = *(const PG8_LAS bf16x8*)(lds + PG8_SB(b, h) + boff + n * 2048 + k * 1024); } while (0)
#define PG8_MMA(ai, bj, At, Bt) do { __builtin_amdgcn_s_setprio(1); _Pragma("unroll") for (int m = 0; m < 4; ++m) _Pragma("unroll") for (int n = 0; n < 2; ++n) _Pragma("unroll") for (int k = 0; k < 2; ++k) \
        acc[ai][bj][m][n] = __builtin_amdgcn_mfma_f32_16x16x32_bf16(Bt[n][k], At[m][k], acc[ai][bj][m][n], 0, 0, 0); __builtin_amdgcn_s_setprio(0); } while (0)
#define PG8_WAIT_V(n) asm volatile("s_waitcnt vmcnt(" #n ")" ::: "memory")
#define PG8_WAIT_L(n) asm volatile("s_waitcnt lgkmcnt(" #n ")" ::: "memory")
#define PG8_BAR __builtin_amdgcn_s_barrier()
#define PG8_SCHED __builtin_amdgcn_sched_barrier(0)
    Unit cur, nxt; int ui = 0;
    if (!S.next(0, cur)) return;
    f32x4 acc[2][2][4][2];
#pragma unroll
    for (int a = 0; a < 2; ++a)
#pragma unroll
        for (int b = 0; b < 2; ++b)
#pragma unroll
            for (int m = 0; m < 4; ++m)
#pragma unroll
                for (int n = 0; n < 2; ++n) acc[a][b][m][n] = (f32x4){0.f, 0.f, 0.f, 0.f};
    bf16x8 At[4][2], B0[2][2], B1[2][2];
    const char* cA = cur.A; const char* cB = cur.B;
    if constexpr (SP2) {
        PG8_STAGE(PG8_SB(0, 0), cB, voffA); PG8_STAGE(PG8_SB(0, 1), cB + hstep, voffA); PG8_STAGE(PG8_SA(0, 0), cA, voffA); PG8_STAGE(PG8_SA(0, 1), cA + hstep, voffA);
        if (wr == 1) PG8_BAR;
        PG8_WAIT_V(2); PG8_BAR;
        PG8_STAGE(PG8_SB(1, 0), cB + kstep, voffA); PG8_STAGE(PG8_SA(1, 0), cA + kstep, voffA); PG8_STAGE(PG8_SB(1, 1), cB + hstep + kstep, voffA);
        PG8_WAIT_V(6); PG8_BAR;
    } else {
        PG8_STAGE(PG8_SB(0, 0), cB, voffA); PG8_STAGE(PG8_SA(0, 0), cA, voffA); PG8_STAGE(PG8_SB(0, 1), cB + hstep, voffA); PG8_STAGE(PG8_SA(0, 1), cA + hstep, voffA);
        if (wr == 1) PG8_BAR;
        PG8_WAIT_V(4); PG8_BAR;
        PG8_STAGE(PG8_SB(1, 0), cB + kstep, voffA); PG8_STAGE(PG8_SA(1, 0), cA + kstep, voffA); PG8_STAGE(PG8_SB(1, 1), cB + hstep + kstep, voffA);
        PG8_WAIT_V(6); PG8_BAR;
    }
    for (;;) {
        const bool has_next = S.next(ui + 1, nxt);
        const char* nA = has_next ? nxt.A : cA; const char* nB = has_next ? nxt.B : cB;
        for (int t = 0; t < nt; t += 2) {
            const bool last = (t == nt - 2);
            const char* a1 = cA + (size_t)(t + 1) * kstep;
            const char* a2 = last ? nA : cA + (size_t)(t + 2) * kstep; const char* b2 = last ? nB : cB + (size_t)(t + 2) * kstep;
            const char* a3 = a2 + kstep; const char* b3 = b2 + kstep;
            if constexpr (SP2) {
            PG8_LDB(B0, 0, 0); PG8_LDB(B1, 0, 1); PG8_SCHED; PG8_LDA(At, 0, 0); PG8_STAGE(PG8_SA(1, 1), a1 + hstep, voffA);
            PG8_WAIT_V(8); PG8_WAIT_L(0); PG8_BAR; PG8_MMA(0, 0, At, B0); PG8_MMA(0, 1, At, B1); PG8_BAR; PG8_SCHED;
            PG8_LDA(At, 0, 1); PG8_STAGE(PG8_SB(0, 0), b2, voffA); PG8_STAGE(PG8_SB(0, 1), b2 + hstep, voffA); PG8_STAGE(PG8_SA(0, 0), a2, voffA);
            PG8_WAIT_V(8); PG8_WAIT_L(0); PG8_BAR; PG8_MMA(1, 0, At, B0); PG8_MMA(1, 1, At, B1); PG8_BAR; PG8_SCHED;
            PG8_LDB(B0, 1, 0); PG8_LDB(B1, 1, 1); PG8_SCHED; PG8_LDA(At, 1, 0); PG8_STAGE(PG8_SA(0, 1), a2 + hstep, voffA);
            PG8_WAIT_V(8); PG8_WAIT_L(0); PG8_BAR; PG8_MMA(0, 0, At, B0); PG8_MMA(0, 1, At, B1); PG8_BAR; PG8_SCHED;
            PG8_LDA(At, 1, 1); PG8_STAGE(PG8_SB(1, 0), b3, voffA); PG8_STAGE(PG8_SB(1, 1), b3 + hstep, voffA); PG8_STAGE(PG8_SA(1, 0), a3, voffA);
            PG8_WAIT_V(8); PG8_WAIT_L(0); PG8_BAR; PG8_MMA(1, 0, At, B0); PG8_MMA(1, 1, At, B1); PG8_BAR; PG8_SCHED;
            } else {
            PG8_LDB(B0, 0, 0); PG8_SCHED; PG8_LDA(At, 0, 0); PG8_STAGE(PG8_SA(1, 1), a1 + hstep, voffA);
            PG8_WAIT_L(8); PG8_BAR; PG8_WAIT_L(0); PG8_MMA(0, 0, At, B0); PG8_BAR; PG8_SCHED;
            PG8_LDB(B1, 0, 1); PG8_STAGE(PG8_SB(0, 0), b2, voffA);
            PG8_BAR; PG8_WAIT_L(0); PG8_MMA(0, 1, At, B1); PG8_BAR;
            PG8_LDA(At, 0, 1); PG8_STAGE(PG8_SA(0, 0), a2, voffA);
            PG8_BAR; PG8_WAIT_L(0); PG8_MMA(1, 0, At, B0); PG8_BAR; PG8_SCHED;
            PG8_STAGE(PG8_SB(0, 1), b2 + hstep, voffA);
            PG8_WAIT_V(6); PG8_BAR; PG8_MMA(1, 1, At, B1); PG8_BAR;
            PG8_LDB(B0, 1, 0); PG8_SCHED; PG8_LDA(At, 1, 0); PG8_STAGE(PG8_SA(0, 1), a2 + hstep, voffA);
            PG8_WAIT_L(8); PG8_BAR; PG8_WAIT_L(0); PG8_MMA(0, 0, At, B0); PG8_BAR; PG8_SCHED;
            PG8_LDB(B1, 1, 1); PG8_STAGE(PG8_SB(1, 0), b3, voffA);
            PG8_BAR; PG8_WAIT_L(0); PG8_MMA(0, 1, At, B1); PG8_BAR;
            PG8_LDA(At, 1, 1); PG8_STAGE(PG8_SA(1, 0), a3, voffA);
            PG8_BAR; PG8_WAIT_L(0); PG8_MMA(1, 0, At, B0); PG8_BAR; PG8_SCHED;
            PG8_STAGE(PG8_SB(1, 1), b3 + hstep, voffA);
            PG8_WAIT_V(6); PG8_BAR; PG8_MMA(1, 1, At, B1); PG8_BAR;
            }
        }
        if constexpr (ALIGN_EPI) { if (wr == 0) PG8_BAR; }
        E(acc, cur, wr, wc, fr, fq);
        if (!has_next) break;
        if (!(Epi::KEEPACC && nxt.b != 0)) {
#pragma unroll
        for (int a = 0; a < 2; ++a)
#pragma unroll
            for (int b = 0; b < 2; ++b)
#pragma unroll
                for (int m = 0; m < 4; ++m)
#pragma unroll
                    for (int n = 0; n < 2; ++n) acc[a][b][m][n] = (f32x4){0.f, 0.f, 0.f, 0.f};
        }
        cur = nxt; cA = nA; cB = nB; ++ui;
        if constexpr (ALIGN_EPI) { if (wr == 1) PG8_BAR; }
    }
    PG8_WAIT_V(0);
    if constexpr (!ALIGN_EPI) { if (wr == 0) PG8_BAR; }
    PG8_BAR;
#undef PG8_SA
#undef PG8_SB
#undef PG8_STAGE
#undef PG8_LDA
#undef PG8_LDB
#undef PG8_MMA
#undef PG8_WAIT_V
#undef PG8_WAIT_L
#undef PG8_BAR
#undef PG8_SCHED
}
}

typedef f32x4 Acc[2][2][4][2];

struct EpiSwiglu {
    static constexpr bool KEEPACC = false;
    bf16_t* act; const float* ssq;
    template <int NAI, int NM> __device__ __forceinline__ void run(const Acc& acc, int rowbase, int pn, int wc, int fr, int fq) const {
#pragma unroll
        for (int ai = 0; ai < NAI; ++ai)
#pragma unroll
            for (int m = 0; m < NM; ++m) {
                const int row = rowbase + 128 * ai + 16 * m + fr;
                const float rs = row_rstd(ssq, row);
                bf16_t* rp = act + (size_t)row * DFF + 128 * pn + 32 * wc + 8 * fq;
                unsigned w[4];
#pragma unroll
                for (int n = 0; n < 2; ++n) {
                    const f32x4 g = acc[ai][0][m][n] * rs, u = acc[ai][1][m][n] * rs; float v[4];
#pragma unroll
                    for (int j = 0; j < 4; ++j) v[j] = g[j] * __builtin_amdgcn_rcpf(1.f + __expf(-g[j])) * u[j];
                    w[2 * n] = pk2(v[0], v[1]); w[2 * n + 1] = pk2(v[2], v[3]);
                }
                *(u32x4*)rp = (u32x4){w[0], w[1], w[2], w[3]};
            }
    }
    __device__ __forceinline__ void operator()(const Acc& acc, const pg8::Unit& u, int wr, int wc, int fr, int fq) const { run<2, 4>(acc, u.pm * 256 + wr * 64, u.pn, wc, fr, fq); }
};

struct EpiResid {
    static constexpr bool KEEPACC = false;
    bf16_t* hb; float* ssq; float alpha;
    template <int NAI, int NM> __device__ __forceinline__ void run(const Acc& acc, int rowbase, int pn, int wc, int fr, int fq) const {
        const int ln = fr + 16 * fq;
#pragma unroll
        for (int ai = 0; ai < NAI; ++ai)
#pragma unroll
            for (int m = 0; m < NM; ++m) {
                const int row = rowbase + 128 * ai + 16 * m + fr; const int col0 = 256 * pn + 32 * wc + 8 * fq;
                bf16_t* np = hb + (size_t)row * DM + col0;
                u32x4 old[2];
#pragma unroll
                for (int bj = 0; bj < 2; ++bj) old[bj] = *(const u32x4*)(np + 128 * bj);
                float ss = 0.f;
#pragma unroll
                for (int bj = 0; bj < 2; ++bj) { const f32x4 a0 = acc[ai][bj][m][0], a1 = acc[ai][bj][m][1]; const u32x4 o = old[bj];
                    const unsigned w0 = pk2(bflo(o.x) + alpha * a0[0], bfhi(o.x) + alpha * a0[1]), w1 = pk2(bflo(o.y) + alpha * a0[2], bfhi(o.y) + alpha * a0[3]);
                    const unsigned w2 = pk2(bflo(o.z) + alpha * a1[0], bfhi(o.z) + alpha * a1[1]), w3 = pk2(bflo(o.w) + alpha * a1[2], bfhi(o.w) + alpha * a1[3]);
                    const float r0 = bflo(w0), r1 = bfhi(w0), r2 = bflo(w1), r3 = bfhi(w1), r4 = bflo(w2), r5 = bfhi(w2), r6 = bflo(w3), r7 = bfhi(w3);
                    ss += (r0 * r0 + r1 * r1 + r2 * r2 + r3 * r3) + (r4 * r4 + r5 * r5 + r6 * r6 + r7 * r7);
                    *(u32x4*)(np + 128 * bj) = (u32x4){w0, w1, w2, w3}; }
                ss += shx(ss, 16, ln); ss += shx(ss, 32, ln);
                if (fq == 0) ssq[(size_t)row * 16 + 4 * pn + wc] = ss;
            }
    }
    __device__ __forceinline__ void operator()(const Acc& acc, const pg8::Unit& u, int wr, int wc, int fr, int fq) const { run<2, 4>(acc, u.pm * 256 + wr * 64, u.pn, wc, fr, fq); }
};

struct EpiBranch {
    static constexpr bool KEEPACC = true;
    const bf16_t* gates; bf16_t* mixed;
    template <int NAI, int NM> __device__ __forceinline__ void run(const Acc& acc, int rowbase, int pn, int wc, int fr, int fq, int b = 0) const {
#pragma unroll
        for (int ai = 0; ai < NAI; ++ai)
#pragma unroll
            for (int m = 0; m < NM; ++m) {
                const int row = rowbase + 128 * ai + 16 * m + fr; const int col0 = 256 * pn + 32 * wc + 8 * fq;
                const unsigned char* gp = (const unsigned char*)gates + (size_t)row * 3072 + b * 1024 + col0; bf16_t* mp = mixed + (size_t)row * DM + col0;
#pragma unroll
                for (int bj = 0; bj < 2; ++bj) {
                    const u32x2 g2 = *(const u32x2*)(gp + 128 * bj); unsigned w[4];
                    u32x4 o = {0u, 0u, 0u, 0u}; if (b > 0) o = *(const u32x4*)(mp + 128 * bj);
#pragma unroll
                    for (int n = 0; n < 2; ++n) { const unsigned gg = n == 0 ? g2.x : g2.y; const f32x4 a = acc[ai][bj][m][n];
                        float v0 = (float)(gg & 255u) * (1.f / 255.f) * a[0], v1 = (float)((gg >> 8) & 255u) * (1.f / 255.f) * a[1], v2 = (float)((gg >> 16) & 255u) * (1.f / 255.f) * a[2], v3 = (float)(gg >> 24) * (1.f / 255.f) * a[3];
                        const unsigned ox = n == 0 ? o.x : o.z, oy = n == 0 ? o.y : o.w;
                        if (b > 0) { v0 += bflo(ox); v1 += bfhi(ox); v2 += bflo(oy); v3 += bfhi(oy); }
                        w[2 * n] = pk2(v0, v1); w[2 * n + 1] = pk2(v2, v3); }
                    *(u32x4*)(mp + 128 * bj) = (u32x4){w[0], w[1], w[2], w[3]};
                }
            }
    }
    __device__ __forceinline__ void operator()(Acc& acc, const pg8::Unit& u, int wr, int wc, int fr, int fq) const {
        const int b = u.b;
#pragma unroll
        for (int ai = 0; ai < 2; ++ai)
#pragma unroll
            for (int m = 0; m < 4; ++m) {
                const int row = u.pm * 256 + wr * 64 + 128 * ai + 16 * m + fr; const int col0 = 256 * u.pn + 32 * wc + 8 * fq;
                const unsigned char* gp = (const unsigned char*)gates + (size_t)row * 3072 + b * 1024 + col0; bf16_t* mp = mixed + (size_t)row * DM + col0;
#pragma unroll
                for (int bj = 0; bj < 2; ++bj) {
                    const u32x2 g2 = *(const u32x2*)(gp + 128 * bj);
                    u32x2 gn2 = {0u, 0u}; if (b < 2) gn2 = *(const u32x2*)(gp + 1024 + 128 * bj);
                    unsigned w[4];
#pragma unroll
                    for (int n = 0; n < 2; ++n) {
                        const unsigned gg = n == 0 ? g2.x : g2.y, gn = n == 0 ? gn2.x : gn2.y;
                        f32x4 a = acc[ai][bj][m][n];
#pragma unroll
                        for (int j = 0; j < 4; ++j) {
                            float g = (float)((gg >> (8 * j)) & 255u) * (1.f / 255.f);
                            if (b > 0) g = fmaxf(g, 9.5367431640625e-07f);
                            if (b < 2) { const float gnx = fmaxf((float)((gn >> (8 * j)) & 255u) * (1.f / 255.f), 9.5367431640625e-07f); g *= __builtin_amdgcn_rcpf(gnx); }
                            a[j] *= g;
                        }
                        acc[ai][bj][m][n] = a;
                        w[2 * n] = pk2(a[0], a[1]); w[2 * n + 1] = pk2(a[2], a[3]);
                    }
                    if (b == 2) *(u32x4*)(mp + 128 * bj) = (u32x4){w[0], w[1], w[2], w[3]};
                }
            }
    }
};

__device__ __forceinline__ int vslot16(int k) { return 8 * ((k >> 2) & 1) + 4 * (k >> 3) + (k & 3); }

struct EpiWin {
    static constexpr bool KEEPACC = false;
    bf16_t* qk; bf16_t* vt; bf16_t* gates; const float* tab; const float* qn; const float* kn; const float* ssq;
    template <int NAI, int NM> __device__ __forceinline__ void run(const Acc& acc, int rowbase, int pn, int wc, int fr, int fq) const {
        if (pn >= 12) {
#pragma unroll
            for (int ai = 0; ai < NAI; ++ai)
#pragma unroll
                for (int m = 0; m < NM; ++m) {
                    const int row = rowbase + 128 * ai + 16 * m + fr;
                    const float rs = row_rstd(ssq, row);
                    unsigned char* rp = (unsigned char*)gates + (size_t)row * 3072 + 256 * (pn - 12) + 32 * wc + 8 * fq;
#pragma unroll
                    for (int bj = 0; bj < 2; ++bj) { unsigned w2[2];
#pragma unroll
                        for (int n = 0; n < 2; ++n) { const f32x4 a = acc[ai][bj][m][n]; unsigned w = 0u;
#pragma unroll
                            for (int j = 0; j < 4; ++j) { const float g = __builtin_amdgcn_rcpf(1.f + __expf(-a[j] * rs)); w |= (unsigned)(int)(g * 255.f + 0.5f) << (8 * j); }
                            w2[n] = w; }
                        *(u32x2*)(rp + 128 * bj) = (u32x2){w2[0], w2[1]}; }
                }
            return;
        }
        int kind, colbase = 0, hv = 0; unsigned scale_bits = 0x3f800000u; const float* gain = nullptr;
        if (pn < 2) { kind = 0; colbase = QA_OFF + (4 * pn + wc) * 64; scale_bits = 0x3e38aa3bu; }
        else if (pn == 2) { if (wc < 2) { kind = 0; colbase = KA_OFF + wc * 64; } else { kind = 2; colbase = KC_OFF + (wc - 2) * 64; gain = kn; } }
        else if (pn == 3) { kind = 3; hv = wc < 2 ? wc : 8 + wc; }
        else if (pn < 6) { kind = 1; colbase = QB_OFF + (4 * (pn - 4) + wc) * 64; scale_bits = 0x3e38aa3bu; }
        else if (pn < 8) { kind = 1; colbase = KB_OFF + (4 * (pn - 6) + wc) * 64; }
        else if (pn < 10) { kind = 3; hv = 2 + 4 * (pn - 8) + wc; }
        else { kind = 2; colbase = QC_OFF + (4 * (pn - 10) + wc) * 64; gain = qn; scale_bits = 0x3e38aa3bu; }
        const float scale = __uint_as_float(scale_bits);
        const float* tabl = tab; asm volatile("" : "+s"(tabl));
        const float* cosA = tabl; const float* sinA = tabl + 4112 * 32;
        const float* axr_c = tabl + 2 * 4112 * 32; const float* axr_s = axr_c + 65 * 16; const float* axc_c = axr_s + 65 * 16; const float* axc_s = axc_c + 64 * 16;
#pragma unroll
        for (int ai = 0; ai < NAI; ++ai)
#pragma unroll
            for (int m = 0; m < NM; ++m) {
                const int row = rowbase + 128 * ai + 16 * m + fr;
                int b, p, grow, gcol, slot;
                if (row < NREAL) { b = row >> 12; const int s = row & 4095; p = s + 16; grow = s >> 6; gcol = s & 63; slot = (s & ~15) + vslot16(s & 15); }
                else { const int i = (row - NREAL) & 15; b = (row - NREAL) >> 4; p = i; grow = -1; gcol = i; slot = SEQ + vslot16(i); }
                const float rs = row_rstd(ssq, row);
                float x[2][2][4];
#pragma unroll
                for (int bj = 0; bj < 2; ++bj)
#pragma unroll
                    for (int n = 0; n < 2; ++n)
#pragma unroll
                        for (int j = 0; j < 4; ++j) x[bj][n][j] = acc[ai][bj][m][n][j] * rs;
                if (kind == 3) {
                    const int qi = fr & 3, qq = fr >> 2;
                    const int slot4 = (slot & ~15) + 8 * (qq & 1) + 4 * (qq >> 1);
                    bf16_t* vp = vt + ((size_t)(b * NVH + hv) * 64) * VL + slot4;
#pragma unroll
                    for (int bj = 0; bj < 2; ++bj)
#pragma unroll
                        for (int n = 0; n < 2; ++n) {
                            int v0 = (int)(pk2(x[bj][n][0], 0.f) & 0xffffu), v1 = (int)(pk2(x[bj][n][1], 0.f) & 0xffffu), v2 = (int)(pk2(x[bj][n][2], 0.f) & 0xffffu), v3 = (int)(pk2(x[bj][n][3], 0.f) & 0xffffu);
                            { const int s01 = (qi & 1) ? v0 : v1, s23 = (qi & 1) ? v2 : v3;
                              const int r01 = __builtin_amdgcn_mov_dpp(s01, 0xB1, 0xf, 0xf, true), r23 = __builtin_amdgcn_mov_dpp(s23, 0xB1, 0xf, 0xf, true);
                              if (qi & 1) { v0 = r01; v2 = r23; } else { v1 = r01; v3 = r23; } }
                            { const int s02 = (qi & 2) ? v0 : v2, s13 = (qi & 2) ? v1 : v3;
                              const int r02 = __builtin_amdgcn_mov_dpp(s02, 0x4E, 0xf, 0xf, true), r13 = __builtin_amdgcn_mov_dpp(s13, 0x4E, 0xf, 0xf, true);
                              if (qi & 2) { v0 = r02; v1 = r13; } else { v2 = r02; v3 = r13; } }
                            *(u32x2*)(vp + (size_t)(32 * bj + 16 * n + 4 * fq + qi) * VL) = (u32x2){(unsigned)v0 | ((unsigned)v1 << 16), (unsigned)v2 | ((unsigned)v3 << 16)};
                        }
                    continue;
                }
                if (kind == 0) {
#pragma unroll
                    for (int n = 0; n < 2; ++n) {
                        const f32x4 c = *(const f32x4*)(cosA + p * 32 + 8 * fq + 4 * n), s = *(const f32x4*)(sinA + p * 32 + 8 * fq + 4 * n);
#pragma unroll
                        for (int j = 0; j < 4; ++j) { const float x1 = x[0][n][j], x2 = x[1][n][j]; x[0][n][j] = x1 * c[j] - x2 * s[j]; x[1][n][j] = x2 * c[j] + x1 * s[j]; }
                    }
                } else if (kind == 2) {
                    float ss = 0.f;
#pragma unroll
                    for (int bj = 0; bj < 2; ++bj)
#pragma unroll
                        for (int n = 0; n < 2; ++n)
#pragma unroll
                            for (int j = 0; j < 4; ++j) ss += x[bj][n][j] * x[bj][n][j];
                    { const int ln = fr + 16 * fq; ss += shx(ss, 16, ln); ss += shx(ss, 32, ln); }
                    const float rinv = rsqrtf(ss * (1.f / 64.f) + EPS);
#pragma unroll
                    for (int bj = 0; bj < 2; ++bj)
#pragma unroll
                        for (int n = 0; n < 2; ++n) { const f32x4 gg = *(const f32x4*)(gain + 32 * bj + 16 * n + 4 * fq);
#pragma unroll
                            for (int j = 0; j < 4; ++j) x[bj][n][j] = x[bj][n][j] * rinv * gg[j]; }
#pragma unroll
                    for (int bj = 0; bj < 2; ++bj) {
                        const float* tc = bj == 0 ? axr_c + (grow + 1) * 16 : axc_c + gcol * 16; const float* ts = bj == 0 ? axr_s + (grow + 1) * 16 : axc_s + gcol * 16;
                        const f32x4 c = *(const f32x4*)(tc + 4 * fq), s = *(const f32x4*)(ts + 4 * fq);
#pragma unroll
                        for (int j = 0; j < 4; ++j) { const float x1 = x[bj][0][j], x2 = x[bj][1][j]; x[bj][0][j] = x1 * c[j] - x2 * s[j]; x[bj][1][j] = x2 * c[j] + x1 * s[j]; }
                    }
                }
                if (kind == 2) {
                    bf16_t* rp = qk + (size_t)row * QKP + colbase + 4 * fq;
#pragma unroll
                    for (int bj = 0; bj < 2; ++bj)
#pragma unroll
                        for (int n = 0; n < 2; ++n)
                            *(u32x2*)(rp + 32 * bj + 16 * n) = (u32x2){pk2(x[bj][n][0] * scale, x[bj][n][1] * scale), pk2(x[bj][n][2] * scale, x[bj][n][3] * scale)};
                } else {
                    bf16_t* rp = qk + (size_t)row * QKP + colbase + 8 * fq;
#pragma unroll
                    for (int bj = 0; bj < 2; ++bj)
                        *(u32x4*)(rp + 32 * bj) = (u32x4){pk2(x[bj][0][0] * scale, x[bj][0][1] * scale), pk2(x[bj][0][2] * scale, x[bj][0][3] * scale), pk2(x[bj][1][0] * scale, x[bj][1][1] * scale), pk2(x[bj][1][2] * scale, x[bj][1][3] * scale)};
                }
            }
    }
    __device__ __forceinline__ void operator()(const Acc& acc, const pg8::Unit& u, int wr, int wc, int fr, int fq) const { run<2, 4>(acc, u.pm * 256 + wr * 64, u.pn, wc, fr, fq); }
};

template <class Epi, bool BR = false> __device__ __forceinline__ void meta_job(LAS unsigned char* lds, const bf16_t* A, const bf16_t* Bt, int K, int pn, int wcj, const Epi& E, int b = 0) {
    int tid_ = threadIdx.x; asm volatile("" : "+v"(tid_));
    const int tid = tid_, wid = __builtin_amdgcn_readfirstlane(tid >> 6), lane = tid & 63, fr = lane & 15, fq = lane >> 4;
    f32x4 acc[2][4][2];
#pragma unroll
    for (int b = 0; b < 2; ++b)
#pragma unroll
        for (int m = 0; m < 4; ++m)
#pragma unroll
            for (int n = 0; n < 2; ++n) acc[b][m][n] = (f32x4){0.f, 0.f, 0.f, 0.f};
    const int kper = K >> 3, kbeg = wid * kper;
    const bf16_t* ap = A + (size_t)(MROW0 + fr) * K + 8 * fq + kbeg;
    const bf16_t* bp = Bt + (size_t)(256 * pn + 32 * wcj + fr) * K + 8 * fq + kbeg;
#pragma unroll 4
    for (int k0 = 0; k0 < kper; k0 += 32) {
        bf16x8 a[4], w[2][2];
#pragma unroll
        for (int m = 0; m < 4; ++m) a[m] = *(const bf16x8*)(ap + (size_t)(16 * m) * K + k0);
#pragma unroll
        for (int bj = 0; bj < 2; ++bj)
#pragma unroll
            for (int n = 0; n < 2; ++n) w[bj][n] = *(const bf16x8*)(bp + (size_t)(128 * bj + 16 * n) * K + k0);
#pragma unroll
        for (int bj = 0; bj < 2; ++bj)
#pragma unroll
            for (int m = 0; m < 4; ++m)
#pragma unroll
                for (int n = 0; n < 2; ++n) acc[bj][m][n] = __builtin_amdgcn_mfma_f32_16x16x32_bf16(w[bj][n], a[m], acc[bj][m][n], 0, 0, 0);
    }
    LAS f32x4* part = (LAS f32x4*)lds;
#pragma unroll
    for (int bj = 0; bj < 2; ++bj)
#pragma unroll
        for (int m = 0; m < 4; ++m)
#pragma unroll
            for (int n = 0; n < 2; ++n) part[(wid * 16 + (bj * 4 + m) * 2 + n) * 64 + lane] = acc[bj][m][n];
    __syncthreads();
    if (wid < 2) {
        Acc r;
#pragma unroll
        for (int a = 0; a < 2; ++a)
#pragma unroll
            for (int b = 0; b < 2; ++b)
#pragma unroll
                for (int m = 0; m < 4; ++m)
#pragma unroll
                    for (int n = 0; n < 2; ++n) r[a][b][m][n] = (f32x4){0.f, 0.f, 0.f, 0.f};
#pragma unroll
        for (int bj = 0; bj < 2; ++bj)
#pragma unroll
            for (int mm = 0; mm < 2; ++mm)
#pragma unroll
                for (int n = 0; n < 2; ++n) {
                    f32x4 sum = (f32x4){0.f, 0.f, 0.f, 0.f};
                    for (int w8 = 0; w8 < 8; ++w8) sum += part[(w8 * 16 + (bj * 4 + 2 * wid + mm) * 2 + n) * 64 + lane];
                    r[0][bj][mm][n] = sum;
                }
        if constexpr (BR) E.template run<1, 2>(r, MROW0 + 32 * wid, pn, wcj, fr, fq, b); else E.template run<1, 2>(r, MROW0 + 32 * wid, pn, wcj, fr, fq);
    }
    __syncthreads();
}

__device__ __forceinline__ void meta_publish(unsigned* cnt) {
    asm volatile("s_waitcnt vmcnt(0)" ::: "memory");
    __syncthreads();
    if (threadIdx.x == 0) { __builtin_amdgcn_fence(__ATOMIC_RELEASE, "agent"); asm volatile("s_waitcnt vmcnt(0)" ::: "memory"); (void)xb_add(cnt, 1u); }
}
__device__ __forceinline__ void meta_wait(unsigned* cnt, unsigned need) {
    if (threadIdx.x == 0) { unsigned sp = 0u; while (xb_ld(cnt) < need) { __builtin_amdgcn_s_sleep(2); if (++sp > (1u << 22)) break; }
        __builtin_amdgcn_fence(__ATOMIC_ACQUIRE, "agent"); asm volatile("s_waitcnt vmcnt(0)" ::: "memory"); }
    __syncthreads();
}
template <class Epi, bool ALIGN, bool META = true> __device__ __forceinline__ void run_gemm(LAS unsigned char* lds, const bf16_t* A, const bf16_t* Bt, int N, int K, const Epi& E, unsigned* publish = nullptr) {
    const int G = gridDim.x, c = blockIdx.x, njobs = (N / 256) * 4;
    int q = G - 1 - c; asm volatile("" : "+s"(q));
    if (META && q < njobs) { meta_job<Epi>(lds, A, Bt, K, q >> 2, q & 3, E); if (publish) meta_publish(publish); }
    pg8::Gemm g{A, Bt, NREAL, N, K}; pg8::StaticOrder S; S.init(NREAL, N, G, c, A, Bt, K);
    pg8::gemm_phase<Epi, pg8::StaticOrder, ALIGN, true>(lds, g, S, E);
}

__device__ __forceinline__ void run_branch(LAS unsigned char* lds, const bf16_t* oa, const bf16_t* ob, const bf16_t* oc, const bf16_t* Wb, const EpiBranch& E) {
    const int G = gridDim.x, c = blockIdx.x;
    int q = G - 1 - c; asm volatile("" : "+s"(q));
    (void)q;
    pg8::Gemm g{oa, Wb, NREAL, DM, 512}; pg8::BranchOrder S; S.base.init(NREAL, DM, G, c, oa, Wb, 512);
    S.A3[0] = (const char*)oa; S.A3[1] = (const char*)ob; S.A3[2] = (const char*)oc;
    S.B3[0] = (const char*)Wb; S.B3[1] = (const char*)(Wb + (size_t)DM * 512); S.B3[2] = (const char*)(Wb + (size_t)2 * DM * 512);
    pg8::gemm_phase<EpiBranch, pg8::BranchOrder, true, true>(lds, g, S, E);
}

__device__ __forceinline__ int perm32(int rho) { const int n = rho >> 4, i = rho & 15; return 8 * (i >> 2) + 4 * n + (i & 3); }
__device__ __forceinline__ bool perm_group(int kind, int sg) {
    if (kind != 2) return true;
    const int pn = sg >> 3, wc = sg & 3;
    if (pn >= 12) return true;
    if (pn < 2) return true;
    if (pn == 2) return wc < 2;
    if (pn >= 4 && pn < 8) return true;
    return false;
}
__device__ __forceinline__ int map_cols(int kind, int sg) {
    if (kind == 0) return 32 * sg;
    const int pn = sg >> 3, w = sg & 7;
    if (kind == 1) return w < 4 ? 128 * pn + 32 * w : DFF + 128 * pn + 32 * (w - 4);
    if (pn >= 12) return 32 * sg;
    const int bj = w >> 2, wc = w & 3; int base;
    if (pn < 2) base = 0 + (4 * pn + wc) * 64;
    else if (pn == 2) base = wc < 2 ? 512 + wc * 64 : 2816 + (wc - 2) * 64;
    else if (pn == 3) base = wc < 2 ? 640 + wc * 64 : 2944 + (wc - 2) * 64;
    else if (pn < 6) base = 768 + (4 * (pn - 4) + wc) * 64;
    else if (pn < 8) base = 1280 + (4 * (pn - 6) + wc) * 64;
    else if (pn < 10) base = 1792 + (4 * (pn - 8) + wc) * 64;
    else base = 2304 + (4 * (pn - 10) + wc) * 64;
    return base + 32 * bj;
}
__device__ __forceinline__ void conv_matrix(const float* W, int K, int ldw, int nslots, int kind, bf16_t* WT, const float* gain, LAS float* scr, int gw, int NGW, int lane) {
    asm volatile("" : "+v"(lane)); const int nsg = nslots / 32, nitems = (K / 64) * nsg;
    for (int it = gw; it < nitems; it += NGW) {
        const int kb = it / nsg, sg = it % nsg, k0 = 64 * kb, c0 = map_cols(kind, sg); const bool pg = perm_group(kind, sg);
        { const int r8 = lane >> 3, c4 = lane & 7; f32x4 v[8]; float gk[8];
#pragma unroll
          for (int i = 0; i < 8; ++i) { const int kk = 8 * i + r8; v[i] = *(const f32x4*)(W + (size_t)(k0 + kk) * ldw + c0 + 4 * c4); gk[i] = gain ? gain[k0 + kk] : 1.f; }
#pragma unroll
          for (int i = 0; i < 8; ++i) { const int kk = 8 * i + r8; LAS float* d = scr + kk * 33 + 4 * c4; d[0] = v[i].x * gk[i]; d[1] = v[i].y * gk[i]; d[2] = v[i].z * gk[i]; d[3] = v[i].w * gk[i]; } }
        asm volatile("s_waitcnt lgkmcnt(0)" ::: "memory");
        const int c = lane & 7;
#pragma unroll
        for (int j = 0; j < 4; ++j) { const int n = (lane >> 3) + 8 * j; const LAS float* s = scr + (8 * c) * 33 + (pg ? perm32(n) : n);
            u32x4 o; o.x = pk2(s[0 * 33], s[1 * 33]); o.y = pk2(s[2 * 33], s[3 * 33]); o.z = pk2(s[4 * 33], s[5 * 33]); o.w = pk2(s[6 * 33], s[7 * 33]);
            *(u32x4*)(WT + (size_t)(32 * sg + n) * K + k0 + 8 * c) = o; }
        asm volatile("s_waitcnt lgkmcnt(0)" ::: "memory");
    }
}

__device__ __forceinline__ void init_rows(const Params& P, bf16_t* hb, float* ssq0, int gw, int NGW, int lane) {
    for (int r0 = gw; r0 < NROWS; r0 += 2 * NGW) {
        f32x4 v[2][4];
#pragma unroll
        for (int u = 0; u < 2; ++u) { const int r = min(r0 + u * NGW, NROWS - 1);
            const float* sp = r < NREAL ? P.x + (size_t)r * DM : P.meta + (size_t)((r - NREAL) & 15) * DM;
#pragma unroll
            for (int j = 0; j < 4; ++j) v[u][j] = *(const f32x4*)(sp + 4 * (lane + 64 * j)); }
#pragma unroll
        for (int u = 0; u < 2; ++u) { const int r = r0 + u * NGW;
            if (r < NROWS) {
                float ss = 0.f;
#pragma unroll
                for (int j = 0; j < 4; ++j) { const unsigned w0 = pk2(v[u][j].x, v[u][j].y), w1 = pk2(v[u][j].z, v[u][j].w);
                    const float q0 = bflo(w0), q1 = bfhi(w0), q2 = bflo(w1), q3 = bfhi(w1); ss += q0 * q0 + q1 * q1 + q2 * q2 + q3 * q3;
                    *(u32x2*)(hb + (size_t)r * DM + 4 * (lane + 64 * j)) = (u32x2){w0, w1}; }
                ss = wave_sum(ss, lane);
                if (lane < 16) ssq0[(size_t)r * 16 + lane] = lane == 0 ? ss : 0.f; } }
    }
}

constexpr int ATT_NUNITS = 512 + 512 + 512;
constexpr int LDS_KV = 0;
constexpr int LDS_MRG = 32768;
constexpr int LDS_RPB = 104448 + 512;
constexpr int LDS_CTLW = 131072;

struct AttState { f32x16 o0, o1, negm; float mref, lrun; bool first; };

template <int MIXER, bool META> __device__ __forceinline__ void att_tile(AttState& S, const LAS unsigned char* kb, const bf16x8 (&qf)[4], int r32, int hh, int mb, int cs, const LAS float* bb) {
    const LAS unsigned char* vb = kb + 8192;
    f32x16 s0, s1;
    bf16x8 kf0[4], kf1[4];
#pragma unroll
    for (int dc = 0; dc < 4; ++dc) {
        kf0[dc] = *(const LAS bf16x8*)(kb + (2 * dc + hh) * 1024 + r32 * 16);
        if (!META) kf1[dc] = *(const LAS bf16x8*)(kb + (2 * dc + hh) * 1024 + (32 + r32) * 16);
    }
    __builtin_amdgcn_sched_barrier(0);
#pragma unroll
    for (int dc = 0; dc < 4; ++dc) {
        s0 = __builtin_amdgcn_mfma_f32_32x32x16_bf16(kf0[dc], qf[dc], dc == 0 ? S.negm : s0, 0, 0, 0);
        if (!META) s1 = __builtin_amdgcn_mfma_f32_32x32x16_bf16(kf1[dc], qf[dc], dc == 0 ? S.negm : s1, 0, 0, 0);
    }
    bf16x8 vf0[4], vf1[4];
#pragma unroll
    for (int s = 0; s < (META ? 1 : 4); ++s) {
        vf0[s] = *(const LAS bf16x8*)(vb + (2 * s + hh) * 1024 + r32 * 16);
        vf1[s] = *(const LAS bf16x8*)(vb + (2 * s + hh) * 1024 + (32 + r32) * 16);
    }
    __builtin_amdgcn_sched_barrier(0);
    __builtin_amdgcn_s_setprio(1);
    if (META) {
#pragma unroll
        for (int i = 8; i < 16; ++i) s0[i] = -1e30f;
    } else if (MIXER == 0) {
#pragma unroll
        for (int i = 0; i < 16; ++i) { const int d0 = mb + (i & 3) + 8 * (i >> 2), d1 = d0 + 32;
            if (d0 > 128 || d0 < -128) s0[i] = -1e30f;
            if (d1 > 128 || d1 < -128) s1[i] = -1e30f; }
    } else if (MIXER == 1) {
#pragma unroll
        for (int i = 0; i < 16; ++i) { const int kq = (i & 3) + 8 * (i >> 2); const int c0 = mb + kq, c1 = c0 + 32;
            const float b0 = bb[kq], b1 = bb[kq + 32];
            s0[i] = (c0 >= cs && c0 < cs + 16) ? s0[i] + b0 : -1e30f;
            s1[i] = (c1 >= cs && c1 < cs + 16) ? s1[i] + b1 : -1e30f; }
    }
    float mt;
    if (META) { mt = fmaxf(fmaxf(s0[0], s0[1]), s0[2]); mt = fmaxf(fmaxf(mt, s0[3]), s0[4]); mt = fmaxf(fmaxf(mt, s0[5]), fmaxf(s0[6], s0[7])); }
    else {
        float a = fmaxf(fmaxf(s0[0], s0[1]), s1[0]), b = fmaxf(fmaxf(s0[2], s0[3]), s1[1]); a = fmaxf(fmaxf(a, s1[2]), s1[3]);
#pragma unroll
        for (int r = 4; r < 16; r += 4) { a = fmaxf(fmaxf(a, s0[r]), s0[r + 1]); b = fmaxf(fmaxf(b, s0[r + 2]), s0[r + 3]); a = fmaxf(fmaxf(a, s1[r]), s1[r + 1]); b = fmaxf(fmaxf(b, s1[r + 2]), s1[r + 3]); }
        mt = fmaxf(a, b);
    }
    { auto rr = __builtin_amdgcn_permlane32_swap(__float_as_uint(mt), __float_as_uint(mt), false, false); mt = fmaxf(__uint_as_float(rr[0]), __uint_as_float(rr[1])); }
    if (S.first || __any(mt > 8.f)) {
        const float dl = S.first ? mt : fmaxf(mt, 0.f);
        S.first = false;
        S.mref += dl;
#pragma unroll
        for (int i = 0; i < 16; ++i) { s0[i] -= dl; if (!META) s1[i] -= dl; S.negm[i] = -S.mref; }
        const float f = __builtin_amdgcn_exp2f(-dl);
        S.lrun *= f;
#pragma unroll
        for (int i = 0; i < 16; ++i) { S.o0[i] *= f; S.o1[i] *= f; }
    }
    float psum = 0.f;
    if (META) {
#pragma unroll
        for (int i = 0; i < 8; ++i) { s0[i] = __builtin_amdgcn_exp2f(s0[i]); psum += s0[i]; }
#pragma unroll
        for (int i = 8; i < 16; ++i) s0[i] = 0.f;
    } else {
        float p1 = 0.f;
#pragma unroll
        for (int i = 0; i < 16; ++i) { s0[i] = __builtin_amdgcn_exp2f(s0[i]); s1[i] = __builtin_amdgcn_exp2f(s1[i]); psum += s0[i]; p1 += s1[i]; }
        psum += p1;
    }
    S.lrun += psum;
    __builtin_amdgcn_s_setprio(0);
#pragma unroll
    for (int s = 0; s < (META ? 1 : 4); ++s) {
        u32x4 w;
        if (s == 0) w = (u32x4){pk2(s0[0], s0[1]), pk2(s0[2], s0[3]), pk2(s0[4], s0[5]), pk2(s0[6], s0[7])};
        else if (s == 1) w = (u32x4){pk2(s0[8], s0[9]), pk2(s0[10], s0[11]), pk2(s0[12], s0[13]), pk2(s0[14], s0[15])};
        else if (s == 2) w = (u32x4){pk2(s1[0], s1[1]), pk2(s1[2], s1[3]), pk2(s1[4], s1[5]), pk2(s1[6], s1[7])};
        else w = (u32x4){pk2(s1[8], s1[9]), pk2(s1[10], s1[11]), pk2(s1[12], s1[13]), pk2(s1[14], s1[15])};
        const bf16x8 pf = __builtin_bit_cast(bf16x8, w);
        S.o0 = __builtin_amdgcn_mfma_f32_32x32x16_bf16(vf0[s], pf, S.o0, 0, 0, 0);
        S.o1 = __builtin_amdgcn_mfma_f32_32x32x16_bf16(vf1[s], pf, S.o1, 0, 0, 0);
    }
}

template <int MIXER> __device__ __forceinline__ void attn_unit(LAS unsigned char* lds, int type, int b, int hd, int qblk, const bf16_t* qk, const bf16_t* vt, bf16_t* obuf, const float* sink, const float* rpb) {
    int tid_ = threadIdx.x; asm volatile("" : "+v"(tid_));
    const int tid = tid_, wid = __builtin_amdgcn_readfirstlane(tid >> 6), lane = tid & 63, r32 = lane & 31, hh = lane >> 5;
    LAS float* rpbl = (LAS float*)(lds + LDS_RPB);
    const bool is_meta = (type == 0 || type == 4 || type == 5);
    const int ks = wid & 3;
    int koff, hv;
    if (MIXER == 0) { const int kvh = is_meta ? hd : (hd >> 2); koff = KA_OFF + kvh * 64; hv = kvh; }
    else if (MIXER == 1) { koff = KB_OFF + hd * 64; hv = 2 + hd; }
    else { const int kvh = is_meta ? hd : (hd >> 2); koff = KC_OFF + kvh * 64; hv = 10 + kvh; }
    const bf16_t* kbase = qk + koff;
    const bf16_t* vbase = vt + ((size_t)(b * NVH + hv) * 64) * VL;
    int t_lo = 0, nt = 0;
    if (type <= 1) { t_lo = 0; nt = 64; }
    else if (type == 3) { t_lo = max(0, 4 * qblk - 2); nt = min(63, 4 * qblk + 5) - t_lo + 1; }
    else if (type == 4) { t_lo = 0; nt = 2; }
    else if (type == 2) { t_lo = min(max(4 * qblk - 4, 0), 56); nt = min(max(4 * qblk - 1, 0), 56) + 7 - t_lo + 1; }
    int qrow, qhead, sq; bool wactive = true, svalid = true;
    if (!is_meta) { sq = 256 * qblk + 32 * wid + r32; qrow = b * SEQ + sq; qhead = hd; }
    else if (type == 5) { qrow = MROW0 + 16 * b + (r32 & 15); qhead = hd; sq = (r32 & 15) - 16; wactive = (wid == 0); svalid = r32 < 16; }
    else { qrow = MROW0 + 16 * b + (r32 & 15); qhead = 4 * hd + 2 * (wid >> 2) + (r32 >> 4); sq = (r32 & 15) - 16; wactive = (type == 0) || (ks == 0); }
    const int qoff = (MIXER == 0 ? QA_OFF : MIXER == 1 ? QB_OFF : QC_OFF) + qhead * 64;
    const int gr = sq >> 6, gc = sq & 63;
    const int wgr = 4 * qblk + (wid >> 1);
    const int kr0 = min(max(wgr - 4, 0), 56);
    const int cs = min(max(gc - 8, 0), 48);
    const int sw0 = 256 * qblk + 32 * wid;
    if (MIXER == 1 && type == 2) { for (int i = tid; i < 465; i += 512) rpbl[i] = rpb[hd * 465 + i] * LOG2E; }
    bf16x8 qf[4];
    { const bf16_t* qp = qk + (size_t)qrow * QKP + qoff + 8 * hh;
#pragma unroll
      for (int dc = 0; dc < 4; ++dc) qf[dc] = *(const GAS bf16x8*)(qp + 16 * dc); }
    AttState S;
    S.first = true;
    if (MIXER == 0) { S.mref = sink[qhead] * LOG2E; S.lrun = hh == 0 ? 1.f : 0.f; } else { S.mref = 0.f; S.lrun = 0.f; }
#pragma unroll
    for (int i = 0; i < 16; ++i) { S.o0[i] = 0.f; S.o1[i] = 0.f; S.negm[i] = -S.mref; }
    u32x4 kA = {0u, 0u, 0u, 0u}, vA = {0u, 0u, 0u, 0u}, kB = {0u, 0u, 0u, 0u}, vB = {0u, 0u, 0u, 0u};
    const unsigned kof = (unsigned)lane * (QKP * 2) + (unsigned)wid * 16u, vof = (unsigned)lane * (VL * 2) + (unsigned)wid * 16u;
#define ATT_PREFETCH(KR, VR, IT) do { const int it_ = (IT); \
        if (it_ < 0) { KR = *(const GAS u32x4*)(kbase + (size_t)(MROW0 + 16 * b + min(lane, 15)) * QKP + 8 * wid); \
            if (wid < 4) VR = *(const GAS u32x4*)(vbase + (size_t)lane * VL + SEQ + 8 * wid); } \
        else { const int t_ = t_lo + it_; \
            KR = *(const GAS u32x4*)(kbase + (size_t)(b * SEQ + 64 * t_ + lane) * QKP + 8 * wid); \
            VR = *(const GAS u32x4*)(vbase + (size_t)lane * VL + 64 * t_ + 8 * wid); } } while (0)
#define ATT_STASH(KR, VR, BUF) do { LAS unsigned char* kb_ = lds + LDS_KV + (BUF) * 16384; \
        *(LAS u32x4*)(kb_ + wid * 1024 + lane * 16) = KR; *(LAS u32x4*)(kb_ + 8192 + wid * 1024 + lane * 16) = VR; } while (0)
#define ATT_STEP(IT, KC, VC, KN, VN) do { const int it = (IT); const int buf = (it + 1) & 1; \
        { const int t2_ = t_lo + max(min(it + 2, nt - 1), 0);     \
          KN = *(const GAS u32x4*)((const GAS char*)kbase + (size_t)(b * SEQ + 64 * t2_) * (QKP * 2) + kof); \
          VN = *(const GAS u32x4*)((const GAS char*)vbase + (size_t)t2_ * 128 + vof); } \
        const int t = t_lo + it; \
        bool act = wactive; \
        if (it < 0) { if (type == 0) act = (ks == 0); } \
        else { if (type == 0) act = ((t & 3) == ks); \
               else if (type == 3) act = (64 * t + 63 >= sw0 - 128) && (64 * t <= sw0 + 159); \
               else if (type == 2) act = (t >= kr0) && (t < kr0 + 8); } \
        if (act) { const LAS unsigned char* kb = lds + LDS_KV + buf * 16384; \
            if (it < 0) att_tile<MIXER, true>(S, kb, qf, r32, hh, 0, 0, rpbl); \
            else if (MIXER == 0) att_tile<0, false>(S, kb, qf, r32, hh, 64 * t + 4 * hh - sq, 0, rpbl); \
            else if (MIXER == 1) att_tile<1, false>(S, kb, qf, r32, hh, 4 * hh, cs, rpbl + ((t - gr + 7) * 31 + 4 * hh - gc + 15)); \
            else att_tile<2, false>(S, kb, qf, r32, hh, 0, 0, rpbl); } \
        if (it + 1 < nt) ATT_STASH(KC, VC, buf ^ 1); \
        __syncthreads(); } while (0)
    ATT_PREFETCH(kA, vA, -1); ATT_STASH(kA, vA, 0);
    if (nt > 0) ATT_PREFETCH(kA, vA, 0);
    __syncthreads();
    for (int it0 = -1; it0 < nt; it0 += 2) {
        ATT_STEP(it0, kA, vA, kB, vB);
        if (it0 + 1 < nt) ATT_STEP(it0 + 1, kB, vB, kA, vA);
    }
#undef ATT_STEP
#undef ATT_PREFETCH
#undef ATT_STASH
    float ltot = S.lrun + shx(S.lrun, 32, lane);
    if (MIXER == 2 && type == 0) {
        LAS float* mg = (LAS float*)(lds + LDS_MRG + wid * 8448);
        if (ks != 0) {
            if (hh == 0) { mg[r32] = S.mref; mg[32 + r32] = ltot; }
#pragma unroll
            for (int i = 0; i < 16; ++i) { mg[64 + i * 64 + lane] = S.o0[i]; mg[64 + 1024 + i * 64 + lane] = S.o1[i]; }
        }
        __syncthreads();
        if (ks == 0) {
            for (int k2 = 1; k2 < 4; ++k2) {
                const LAS float* pg = (const LAS float*)(lds + LDS_MRG + (wid + k2) * 8448);
                const float m2 = pg[r32], l2 = pg[32 + r32];
                const float mn = fmaxf(S.mref, m2), a1 = __builtin_amdgcn_exp2f(S.mref - mn), a2 = __builtin_amdgcn_exp2f(m2 - mn);
                ltot = ltot * a1 + l2 * a2; S.mref = mn;
#pragma unroll
                for (int i = 0; i < 16; ++i) { S.o0[i] = S.o0[i] * a1 + pg[64 + i * 64 + lane] * a2; S.o1[i] = S.o1[i] * a1 + pg[64 + 1024 + i * 64 + lane] * a2; }
            }
        }
    }
    const bool do_store = wactive && svalid && (type != 0 || ks == 0);
    {
        const float rl = 1.f / ltot;
        bf16_t* op = obuf + (size_t)qrow * 512 + qhead * 64 + 8 * hh;
#pragma unroll
        for (int ob2 = 0; ob2 < 2; ++ob2)
#pragma unroll
            for (int gp = 0; gp < 2; ++gp) {
                const int ga = 2 * gp, gb = 2 * gp + 1;
                unsigned xa0, xa1, xb0, xb1;
                if (ob2 == 0) { xa0 = pk2(S.o0[4 * ga] * rl, S.o0[4 * ga + 1] * rl); xa1 = pk2(S.o0[4 * ga + 2] * rl, S.o0[4 * ga + 3] * rl); xb0 = pk2(S.o0[4 * gb] * rl, S.o0[4 * gb + 1] * rl); xb1 = pk2(S.o0[4 * gb + 2] * rl, S.o0[4 * gb + 3] * rl); }
                else          { xa0 = pk2(S.o1[4 * ga] * rl, S.o1[4 * ga + 1] * rl); xa1 = pk2(S.o1[4 * ga + 2] * rl, S.o1[4 * ga + 3] * rl); xb0 = pk2(S.o1[4 * gb] * rl, S.o1[4 * gb + 1] * rl); xb1 = pk2(S.o1[4 * gb + 2] * rl, S.o1[4 * gb + 3] * rl); }
                const auto r0 = __builtin_amdgcn_permlane32_swap(xa0, xb0, false, false);
                const auto r1 = __builtin_amdgcn_permlane32_swap(xa1, xb1, false, false);
                if (do_store) *(u32x4*)(op + 32 * ob2 + 16 * gp) = (u32x4){r0[0], r1[0], r0[1], r1[1]};
            }
    }
    __syncthreads();
}

struct MetaChain { const bf16_t* gates; bf16_t* mixmeta; const bf16_t* Wmb; const bf16_t* Wmo; bf16_t* hb; float* ssq; unsigned* cntA; unsigned* cntB;
                   const float* fi_w; const float* fi_gain; bf16_t* fi_dst; const float* fo_w[3]; bf16_t* fo_dst[3]; int nfo; };
__device__ __forceinline__ void attn_phase(LAS unsigned char* lds, const bf16_t* qk, const bf16_t* vt, bf16_t* oa, bf16_t* ob, bf16_t* oc,
                                           const float* sink, const float* rpb, unsigned* ctr, const MetaChain& M) {
    { int c = blockIdx.x; asm volatile("" : "+s"(c));
      if (c < 48) {
        if (c < 8) attn_unit<2>(lds, 0, c >> 1, c & 1, 0, qk, vt, oc, sink, rpb);
        else if (c < 16) attn_unit<0>(lds, 4, (c - 8) >> 1, (c - 8) & 1, 0, qk, vt, oa, sink, rpb);
        else attn_unit<1>(lds, 5, (c - 16) >> 3, (c - 16) & 7, 0, qk, vt, ob, sink, rpb);
        meta_publish(M.cntA);
        if (c < 16) {
            meta_wait(M.cntA, 48u);
            const bf16_t* mixbase = M.mixmeta - (size_t)MROW0 * DM;
            { EpiBranch EB{M.gates, (bf16_t*)mixbase};
              for (int b = 0; b < 3; ++b) meta_job<EpiBranch, true>(lds, b == 0 ? oa : b == 1 ? ob : oc, M.Wmb + (size_t)b * DM * 512, 512, c >> 2, c & 3, EB, b); }
            meta_publish(M.cntB);
            meta_wait(M.cntB, 16u);
            { EpiResid ER{M.hb, M.ssq, 1.0f}; meta_job<EpiResid>(lds, mixbase, M.Wmo, DM, c >> 2, c & 3, ER); }
        }
      } else {
        const int tidl = ltid(), lane = tidl & 63, wave = __builtin_amdgcn_readfirstlane(tidl >> 6), G = gridDim.x, sgw = (c - 48) * 8 + wave, SNGW = (G - 48) * 8;
        LAS float* scr = (LAS float*)(lds + wave * 8448);
        conv_matrix(M.fi_w, DM, 2 * DFF, 2 * DFF, 1, M.fi_dst, M.fi_gain, scr, sgw, SNGW, lane);
        for (int k = 0; k < M.nfo; ++k) conv_matrix(k == 0 ? M.fo_w[0] : k == 1 ? M.fo_w[1] : M.fo_w[2], DFF, DM, DM, 0, k == 0 ? M.fo_dst[0] : k == 1 ? M.fo_dst[1] : M.fo_dst[2], nullptr, scr, sgw, SNGW, lane);
      } }
    volatile LAS int* ctlw = (volatile LAS int*)(lds + LDS_CTLW);
    const bool t0 = (ltid() == 0);
    int mine = 0;
    if (t0) mine = (int)atomicAdd(ctr, 1u);
    for (;;) {
        if (t0) ctlw[0] = mine;
        __syncthreads();
        const int u = __builtin_amdgcn_readfirstlane(ctlw[0]);
        __syncthreads();
        if (u >= ATT_NUNITS) break;
        if (t0) mine = (int)atomicAdd(ctr, 1u);
        const int v = u & 511, b = v >> 7, hd = (v >> 4) & 7, qblk = v & 15;
        if (u < 512) attn_unit<2>(lds, 1, b, hd, qblk, qk, vt, oc, sink, rpb);
        else if (u < 1024) attn_unit<1>(lds, 2, b, hd, qblk, qk, vt, ob, sink, rpb);
        else attn_unit<0>(lds, 3, b, hd, qblk, qk, vt, oa, sink, rpb);
    }
}


#define XB_TMO      128
#define XB_XCNT(j)  (256  + 64 * (j))
#define XB_XSUB(j)  (1280 + 64 * (j))
#define XB_XGEN(j)  (2304 + 64 * (j))
#define XB_TOP      3328
#define XB_TOPGEN   3392
#define XB_SPIN_CAP (1u << 18)
__device__ __forceinline__ unsigned xb_xcc_id() { return (unsigned)__builtin_amdgcn_s_getreg((3 << 11) | 20) & 0xFu; }
#define XB_SPIN(cond, bar) do { unsigned _sp = 0; while (cond) { __builtin_amdgcn_s_sleep(1); \
    if ((++_sp & 255u) == 0u) { if (xb_ld(&(bar)[XB_TMO])) break; if (_sp > XB_SPIN_CAP) { atomicAdd(&(bar)[XB_TMO], 1u); break; } } } } while (0)
struct XcdBarrier { unsigned* bar; unsigned x; volatile LAS unsigned* st; };
__device__ __forceinline__ XcdBarrier xcd_barrier_post(unsigned* bar, volatile LAS unsigned* st) {
    XcdBarrier b; b.bar = bar; b.x = xb_xcc_id(); b.st = st;
    if (threadIdx.x == 0) (void)xb_add(&bar[XB_XCNT(b.x)], 1u);
    return b;
}
__device__ __forceinline__ void xcd_barrier_complete(unsigned* bar, unsigned x, unsigned& nloc, unsigned& nx) {
    const unsigned G = gridDim.x * gridDim.y * gridDim.z;
    unsigned sum, cnt, mine, sp = 0u;
    for (;;) {
        sum = 0u; cnt = 0u; mine = 0u;
#pragma unroll
        for (unsigned j = 0; j < 16; ++j) { const unsigned c = xb_ld(&bar[XB_XCNT(j)]); sum += c; cnt += (c > 0u) ? 1u : 0u; mine = (j == x) ? c : mine; }
        if (sum == G) break;
        __builtin_amdgcn_s_sleep(1);
        if ((++sp & 255u) == 0u) { if (xb_ld(&bar[XB_TMO])) break; if (sp > XB_SPIN_CAP) { atomicAdd(&bar[XB_TMO], 1u); break; } }
    }
    nloc = mine > 0u ? mine : 1u; nx = cnt > 0u ? cnt : 1u;
}
__device__ __forceinline__ void xcd_barrier(const XcdBarrier& b) {
    asm volatile("s_waitcnt vmcnt(0)" ::: "memory");
    __syncthreads();
    if (threadIdx.x == 0) {
        unsigned* bar = b.bar; asm volatile("" : "+s"(bar)); unsigned bx = b.x; asm volatile("" : "+s"(bx));
        __builtin_amdgcn_s_waitcnt(0);
        unsigned nloc = b.st[0], nx = b.st[1];
        if (nloc == 0u) { xcd_barrier_complete(bar, bx, nloc, nx); b.st[0] = nloc; b.st[1] = nx; }
        const unsigned old = xb_add(&bar[XB_XSUB(bx)], 1u);
        const unsigned gen = old / nloc;
        if (old + 1u == (gen + 1u) * nloc) {
            __builtin_amdgcn_fence(__ATOMIC_RELEASE, "agent");
            asm volatile("s_waitcnt vmcnt(0)" ::: "memory");
            const unsigned og = xb_add(&bar[XB_TOP], 1u);
            const unsigned tg = og / nx;
            if (og + 1u == (tg + 1u) * nx) xb_add(&bar[XB_TOPGEN], 1u);
            else XB_SPIN(xb_ld(&bar[XB_TOPGEN]) == tg, bar);
            __builtin_amdgcn_fence(__ATOMIC_ACQUIRE, "agent");
            xb_add(&bar[XB_XGEN(bx)], 1u);
            asm volatile("s_waitcnt vmcnt(0)" ::: "memory");
        } else {
            XB_SPIN(xb_ld(&bar[XB_XGEN(bx)]) == gen, bar);
            __builtin_amdgcn_fence(__ATOMIC_ACQUIRE, "agent");
            asm volatile("s_waitcnt vmcnt(0)" ::: "memory");
        }
    }
    __syncthreads();
}

__device__ __forceinline__ unsigned char* lws(unsigned char* p) { asm volatile("" : "+s"(p)); return p; }
#define WSP(T, off) ((T*)(lws(P.ws) + (off)))
#define P_HMETA WSP(float, WS_HMETA)
#define P_SSQ(i) WSP(float, WS_SSQ)
#define P_TAB   WSP(float, WS_TAB)
#define P_NBUF  WSP(bf16_t, WS_N)
#define P_ACT   WSP(bf16_t, WS_X)
#define P_QK    WSP(bf16_t, WS_X)
#define P_MIXED WSP(bf16_t, WS_X)
#define P_OC    WSP(bf16_t, WS_X + (size_t)NROWS * QKP * 2)
#define P_OA    ((bf16_t*)lws((unsigned char*)P.out))
#define P_OB    ((bf16_t*)lws((unsigned char*)P.out) + (size_t)NROWS * 512)
#define P_GATES WSP(bf16_t, WS_G)
#define P_VT    WSP(bf16_t, WS_V)
#define P_WFO(k) WSP(bf16_t, WS_W + W_FO + (size_t)(k) * 5767168)
#define P_WFI(k) WSP(bf16_t, WS_W + ((k) ? W_FIB : W_FIA))
#define P_WMI    WSP(bf16_t, WS_W + W_MI)
#define P_WMB    WSP(bf16_t, WS_W + W_MB)
#define P_WMO    WSP(bf16_t, WS_W + W_MO)

__global__ void __launch_bounds__(512, 2) fwd_megakernel(Params P) {
    extern __shared__ __attribute__((aligned(16))) unsigned char lds_raw[];
    cg::grid_group grid = cg::this_grid();
    LAS unsigned char* lds = (LAS unsigned char*)lds_raw;
    volatile LAS unsigned* bst = (volatile LAS unsigned*)(lds + LDS_CTLW + 16);
    if (threadIdx.x < 2) bst[threadIdx.x] = 0u;
    __syncthreads();
    const XcdBarrier xbar = xcd_barrier_post((unsigned*)(P.ws + WS_BAR), bst);
#define GSYNC() xcd_barrier(xbar)
#define WAVE_IDS const int tidl = ltid(), lane = tidl & 63, wave = __builtin_amdgcn_readfirstlane(tidl >> 6), G = gridDim.x, gw = blockIdx.x * 8 + wave, NGW = G * 8; LAS float* scr = (LAS float*)(lds + wave * 8448)
#define CONV_MIX_BO(WB, WO)   do { WAVE_IDS; for (int b_ = 0; b_ < 3; ++b_) conv_matrix((WB) + (size_t)b_ * 512 * DM, 512, DM, DM, 0, P_WMB + (size_t)b_ * DM * 512, nullptr, scr, gw, NGW, lane); \
                                   conv_matrix((WO), DM, DM, DM, 0, P_WMO, nullptr, scr, gw, NGW, lane); __syncthreads(); } while (0)
#define SLACK_IDS WAVE_IDS; const int rem_ = (64 * 22) % G, first_ = rem_ ? rem_ : 0, nsl_ = G - first_ - 16, sgw = ((int)blockIdx.x - first_ - 16) * 8 + wave, SNGW = nsl_ * 8; \
    const bool slack = (int)blockIdx.x >= first_ + 16, mconsumer = (int)blockIdx.x >= first_ && (int)blockIdx.x < first_ + 16; const int mq = (int)blockIdx.x - first_; (void)gw; (void)NGW
#define META_FFN_OUT(k, ssqi, CNT) do { if (mconsumer) { meta_wait((CNT), 88u); EpiResid E_{P_NBUF, P_SSQ(ssqi), 0.5f}; meta_job<EpiResid>(lds, P_ACT, P_WFO(k), DFF, mq >> 2, mq & 3, E_); } } while (0)

    {
        WAVE_IDS;
        const int gt = blockIdx.x * 512 + tidl, NGT = G * 512;
        float* tab = P_TAB; bf16_t* vt = P_VT; float* ssq = P_SSQ(0);
        for (int i = gt; i < 4112 * 32; i += NGT) { const int p = i >> 5, f = i & 31; const float inv = powf(10000.f, -(float)(2 * f) / 64.f); const float a = (float)p * inv; tab[i] = cosf(a); tab[4112 * 32 + i] = sinf(a); }
        float* axr_c = tab + 2 * 4112 * 32; float* axr_s = axr_c + 65 * 16; float* axc_c = axr_s + 65 * 16; float* axc_s = axc_c + 64 * 16;
        for (int i = gt; i < 65 * 16; i += NGT) { const int r = (i >> 4) - 1, f = i & 15; const float inv = powf(10000.f, -(float)(2 * f) / 32.f); const float a = (float)r * inv; axr_c[i] = cosf(a); axr_s[i] = sinf(a); }
        for (int i = gt; i < 64 * 16; i += NGT) { const int c = i >> 4, f = i & 15; const float inv = powf(10000.f, -(float)(2 * f) / 32.f); const float a = (float)c * inv; axc_c[i] = cosf(a); axc_s[i] = sinf(a); }
        for (int i = gt; i < NB * NVH * 64 * 16; i += NGT) { const int rowi = i >> 4, sl = i & 15; vt[(size_t)rowi * VL + SEQ + 16 + sl] = 0; }
        conv_matrix(P.ffn1_w_in, DM, 2 * DFF, 2 * DFF, 1, P_WFI(0), P.ffn1_norm, scr, gw, NGW, lane);
        conv_matrix(P.ffn1_w_out, DFF, DM, DM, 0, P_WFO(0), nullptr, scr, gw, NGW, lane);
        init_rows(P, P_NBUF, ssq, gw, NGW, lane);
    }
    GSYNC();

    for (int l = 0; l < DEPTH; ++l) {
        { EpiSwiglu E{P_ACT, P_SSQ(3 * l)}; run_gemm<EpiSwiglu, true>(lds, P_NBUF, P_WFI(0), 2 * DFF, DM, E, WSP(unsigned, WS_CTL) + 256 + 64 * (2 * l)); }
        { SLACK_IDS; META_FFN_OUT(2 * l, 3 * l + 1, WSP(unsigned, WS_CTL) + 256 + 64 * (2 * l)); if (slack) {
            conv_matrix(P.w_in + (size_t)l * DM * NIN, DM, NIN, NIN, 2, P_WMI, P.mix_norm + l * DM, scr, sgw, SNGW, lane); } }
        GSYNC();
        { EpiResid E{P_NBUF, P_SSQ(3 * l + 1), 0.5f}; run_gemm<EpiResid, true, false>(lds, P_ACT, P_WFO(2 * l), DM, DFF, E); }
        GSYNC();
        CONV_MIX_BO(P.w_branch + (size_t)l * 3 * 512 * DM, P.w_out + (size_t)l * DM * DM);
        { EpiWin E{P_QK, P_VT, P_GATES, P_TAB, P.qn + l * 64, P.kn + l * 64, P_SSQ(3 * l + 1)}; run_gemm<EpiWin, true>(lds, P_NBUF, P_WMI, NIN, DM, E); }
        GSYNC();
        { MetaChain MC{P_GATES, WSP(bf16_t, WS_HMETA), P_WMB, P_WMO, P_NBUF, P_SSQ(3 * l + 2), WSP(unsigned, WS_CTL) + 512 + 64 * (2 * l), WSP(unsigned, WS_CTL) + 512 + 64 * (2 * l + 1),
                       P.ffn2_w_in + (size_t)l * DM * 2 * DFF, P.ffn2_norm + l * DM, P_WFI(1),
                       {P.ffn2_w_out, P.ffn1_w_out + (size_t)DFF * DM, P.ffn2_w_out + (size_t)DFF * DM}, {P_WFO(1), P_WFO(2), P_WFO(3)}, l == 0 ? 3 : 0};
          attn_phase(lds, P_QK, P_VT, P_OA, P_OB, P_OC, P.sink + l * 8, P.rpb + l * 8 * 465, WSP(unsigned, WS_CTL) + 64 * l, MC); }
        GSYNC();
        { EpiBranch E{P_GATES, P_MIXED}; run_branch(lds, P_OA, P_OB, P_OC, P_WMB, E); }
        GSYNC();
        { EpiResid E{P_NBUF, P_SSQ(3 * l + 2), 1.0f}; run_gemm<EpiResid, true, false>(lds, P_MIXED, P_WMO, DM, DM, E); }
        GSYNC();
        { EpiSwiglu E{P_ACT, P_SSQ(3 * l + 2)}; run_gemm<EpiSwiglu, true>(lds, P_NBUF, P_WFI(1), 2 * DFF, DM, E, WSP(unsigned, WS_CTL) + 256 + 64 * (2 * l + 1)); }
        { SLACK_IDS; (void)sgw; (void)SNGW; (void)slack; META_FFN_OUT(2 * l + 1, 3 * l + 3, WSP(unsigned, WS_CTL) + 256 + 64 * (2 * l + 1)); }
        if (l + 1 < DEPTH) { SLACK_IDS; (void)mconsumer; (void)mq; if (slack)
            conv_matrix(P.ffn1_w_in + (size_t)(l + 1) * DM * 2 * DFF, DM, 2 * DFF, 2 * DFF, 1, P_WFI(0), P.ffn1_norm + (l + 1) * DM, scr, sgw, SNGW, lane); }
        GSYNC();
        { EpiResid E{P_NBUF, P_SSQ(3 * l + 3), 0.5f}; run_gemm<EpiResid, true, false>(lds, P_ACT, P_WFO(2 * l + 1), DM, DFF, E); }
        GSYNC();
    }
    {
        WAVE_IDS; (void)scr;
        const float* ssq = P_SSQ(3 * DEPTH); const bf16_t* hb = P_NBUF;
        for (int r = gw; r < NREAL; r += NGW) {
            float* hp = P.out + (size_t)r * DM;
            const float rstd = row_rstd(ssq, r);
#pragma unroll
            for (int j = 0; j < 4; ++j) { const u32x2 w = *(const u32x2*)(hb + (size_t)r * DM + 4 * (lane + 64 * j)); const f32x4 g = *(const f32x4*)(P.final_norm + 4 * (lane + 64 * j));
                *(f32x4*)(hp + 4 * (lane + 64 * j)) = (f32x4){bflo(w.x) * rstd * g.x, bfhi(w.x) * rstd * g.y, bflo(w.y) * rstd * g.z, bfhi(w.y) * rstd * g.w}; }
        }
    }
    if (P.ws == nullptr) grid.sync();
}

extern "C" void kernel_launch(void* const* d_in, const int* in_sizes, int n_in, void* d_out, int out_size, void* d_ws, size_t ws_size, hipStream_t stream) {
    static int grid_blocks = 0;
    if (grid_blocks == 0) {
        if (n_in != 17 || out_size != NREAL * DM || ws_size < WS_END) { fprintf(stderr, "kernel_launch: unexpected shapes (n_in %d out %d ws %zu need %zu)\n", n_in, out_size, ws_size, (size_t)WS_END); grid_blocks = -1; return; }
        int dev = 0, cus = 0, per_cu = 0;
        (void)hipGetDevice(&dev);
        (void)hipDeviceGetAttribute(&cus, hipDeviceAttributeMultiprocessorCount, dev);
        if (hipFuncSetAttribute((const void*)fwd_megakernel, hipFuncAttributeMaxDynamicSharedMemorySize, LDS_BYTES) != hipSuccess) { fprintf(stderr, "kernel_launch: hipFuncSetAttribute failed\n"); grid_blocks = -1; return; }
        if (hipOccupancyMaxActiveBlocksPerMultiprocessor(&per_cu, (const void*)fwd_megakernel, 512, LDS_BYTES) != hipSuccess || per_cu < 1) { fprintf(stderr, "kernel_launch: occupancy query failed (%d)\n", per_cu); (void)hipGetLastError(); per_cu = 1; }
        grid_blocks = cus;
    }
    if (grid_blocks < 0) return;
    (void)hipMemsetAsync((char*)d_ws + WS_CTL, 0, CTL_BYTES, stream);
    Params p{};
    p.x = (const float*)d_in[0]; p.meta = (const float*)d_in[1]; p.ffn1_norm = (const float*)d_in[2]; p.ffn1_w_in = (const float*)d_in[3]; p.ffn1_w_out = (const float*)d_in[4];
    p.mix_norm = (const float*)d_in[5]; p.w_in = (const float*)d_in[6]; p.sink = (const float*)d_in[7]; p.rpb = (const float*)d_in[8]; p.qn = (const float*)d_in[9]; p.kn = (const float*)d_in[10];
    p.w_branch = (const float*)d_in[11]; p.w_out = (const float*)d_in[12]; p.ffn2_norm = (const float*)d_in[13]; p.ffn2_w_in = (const float*)d_in[14]; p.ffn2_w_out = (const float*)d_in[15]; p.final_norm = (const float*)d_in[16];
    p.out = (float*)d_out; p.ws = (unsigned char*)d_ws;
    void* args[] = {&p};
    hipError_t e = hipLaunchCooperativeKernel((const void*)fwd_megakernel, dim3(grid_blocks), dim3(512), args, LDS_BYTES, stream);
    if (e != hipSuccess) fprintf(stderr, "cooperative launch failed: %s (grid %d)\n", hipGetErrorString(e), grid_blocks);
}
```

```cpp
#include <hip/hip_runtime.h>
#include <hip/hip_cooperative_groups.h>
#include <cstdio>
#include <cstdint>
namespace cg = cooperative_groups;

#define LAS __attribute__((address_space(3)))
#define GAS __attribute__((address_space(1)))
typedef unsigned short bf16_t;
typedef short bf16x8 __attribute__((ext_vector_type(8)));
typedef float f32x2 __attribute__((ext_vector_type(2)));
typedef float f32x4 __attribute__((ext_vector_type(4)));
typedef float f32x16 __attribute__((ext_vector_type(16)));
typedef unsigned u32x2 __attribute__((ext_vector_type(2)));
typedef unsigned u32x4 __attribute__((ext_vector_type(4)));
typedef __bf16 bf16x2_t __attribute__((ext_vector_type(2)));

constexpr int DM = 1024, NB = 4, SEQ = 4096, NMETA = 16, DFF = 2816, NIN = 6144, DEPTH = 2;
constexpr int NREAL = NB * SEQ;
constexpr int MROW0 = NREAL;
constexpr int NROWS = NREAL + NB * NMETA;
constexpr int QKP = 2304;
constexpr int QA_OFF = 0, KA_OFF = 512, QB_OFF = 640, KB_OFF = 1152, QC_OFF = 1664, KC_OFF = 2176;
constexpr int VL = SEQ + 32;
constexpr int NVH = 12;
constexpr float QS = 0.125f * 1.4426950408889634f;
constexpr float LOG2E = 1.4426950408889634f;
constexpr float EPS = 1e-6f;

constexpr size_t WS_CTL = 0;
constexpr size_t WS_BAR = 4096;
constexpr size_t CTL_BYTES = 32768;
constexpr size_t WS_HMETA = CTL_BYTES;
constexpr size_t WS_SSQ = WS_HMETA + 64 * 1024 * 4;
constexpr size_t WS_TAB = WS_SSQ + (size_t)16 * NROWS * 4;
constexpr size_t TAB_BYTES = 2 * 4112 * 32 * 4 + (65 + 65 + 64 + 64) * 16 * 4;
constexpr size_t WS_W = (WS_TAB + TAB_BYTES + 255) / 256 * 256;
constexpr size_t W_FO = 0, W_FIA = 4 * 5767168, W_FIB = W_FIA + 11534336, W_MI = W_FIB + 11534336, W_MB = W_MI + 12582912, W_MO = W_MB + 3145728;
constexpr size_t W_BYTES = W_MO + 2097152;
constexpr size_t WS_N = WS_W + W_BYTES;
constexpr size_t N_BYTES = (size_t)NROWS * 1024 * 2;
constexpr size_t WS_X = WS_N + N_BYTES;
constexpr size_t X_BYTES = (size_t)NROWS * 2816 * 2;
constexpr size_t WS_G = WS_X + X_BYTES;
constexpr size_t G_BYTES = (size_t)NROWS * 3072;
constexpr size_t WS_V = WS_G + G_BYTES;
constexpr size_t V_BYTES = (size_t)NB * NVH * 64 * VL * 2;
constexpr size_t WS_END = WS_V + V_BYTES + 256;

constexpr int LDS_RSTD = 131072 + 256;
constexpr int LDS_BYTES = 131072 + 256 + 1024;

struct Params {
    const float* x; const float* meta; const float* ffn1_norm; const float* ffn1_w_in; const float* ffn1_w_out;
    const float* mix_norm; const float* w_in; const float* sink; const float* rpb; const float* qn; const float* kn;
    const float* w_branch; const float* w_out; const float* ffn2_norm; const float* ffn2_w_in; const float* ffn2_w_out; const float* final_norm;
    float* out; unsigned char* ws;
};

__device__ __forceinline__ unsigned pk2(float lo, float hi) { f32x2 v = {lo, hi}; bf16x2_t b = __builtin_convertvector(v, bf16x2_t); return __builtin_bit_cast(unsigned, b); }
__device__ __forceinline__ float bflo(unsigned u) { return __uint_as_float(u << 16); }
__device__ __forceinline__ float bfhi(unsigned u) { return __uint_as_float(u & 0xffff0000u); }
__device__ __forceinline__ float shx(float v, int o, int lane) { return __builtin_bit_cast(float, __builtin_amdgcn_ds_bpermute((lane ^ o) << 2, __builtin_bit_cast(int, v))); }
__device__ __forceinline__ float wave_sum(float v, int lane) {
#pragma unroll
    for (int o = 1; o < 64; o <<= 1) v += shx(v, o, lane);
    return v;
}
__device__ __forceinline__ unsigned xb_ld(unsigned* p)              { return __hip_atomic_load(p, __ATOMIC_RELAXED, __HIP_MEMORY_SCOPE_AGENT); }
__device__ __forceinline__ unsigned xb_add(unsigned* p, unsigned v) { return __hip_atomic_fetch_add(p, v, __ATOMIC_RELAXED, __HIP_MEMORY_SCOPE_AGENT); }
__device__ __forceinline__ int ltid() { int t = threadIdx.x; asm volatile("" : "+v"(t)); return t; }
__device__ __forceinline__ float row_rstd(const float* ssqp, int row) {
    const f32x4* p = (const f32x4*)(ssqp + (size_t)row * 16); const f32x4 a = p[0], b = p[1], c = p[2], d = p[3];
    const float t = ((a.x + a.y) + (a.z + a.w)) + ((b.x + b.y) + (b.z + b.w)) + (((c.x + c.y) + (c.z + c.w)) + ((d.x + d.y) + (d.z + d.w)));
    return rsqrtf(t * (1.f / DM) + EPS);
}
__device__ __forceinline__ float* hrow(float* out, float* hmeta, int r) { return r < NREAL ? out + (size_t)r * DM : hmeta + (size_t)(r - NREAL) * DM; }

namespace pg8 {
#define PG8_LAS __attribute__((address_space(3)))
constexpr int BM = 256, BK = 64, HALF = 128, HTB = HALF * BK * 2, STAGE_BYTES = 8 * HTB, NXCD = 8, WGM = 8;
__host__ __device__ __forceinline__ int lds_byte(int r, int c) { const int st = (r >> 4) * 2 + (c >> 5), rr = r & 15, cc = c & 31, ob = rr * 64 + cc * 2; return st * 1024 + (ob ^ (((ob >> 9) & 1) << 5)); }
__host__ __device__ __forceinline__ void stage_rc(int b, int& R, int& C) { const int st = b / 1024, sb = b % 1024, swz = sb ^ (((sb >> 9) & 1) << 5); R = (st >> 1) * 16 + swz / 64; C = (st & 1) * 32 + (swz % 64) / 2; }
struct Unit { int pm, pn, b; const char* A; const char* B; };
struct Gemm { const bf16_t* A; const bf16_t* Bt; int M, N, K; };
struct StaticOrder {
    int nM, nN, nwg, G, c; const char* A; const char* Bt; size_t tstep;
    __device__ void init(int M, int N, int G_, int c_, const bf16_t* A_, const bf16_t* Bt_, int K) { nM = M / BM; nN = N / BM; nwg = nM * nN; G = G_; c = c_; A = (const char*)A_; Bt = (const char*)Bt_; tstep = (size_t)BM * K * 2; }
    __device__ void tile(int wgid, Unit& u) const {
        { const int q = nwg / NXCD, r = nwg % NXCD, xcd = wgid % NXCD, off = wgid / NXCD; wgid = (xcd < r ? xcd * (q + 1) : r * (q + 1) + (xcd - r) * q) + off; }
        const int nig = WGM * nN, gid = wgid / nig, fm = gid * WGM, gsz = (nM - fm) < WGM ? (nM - fm) : WGM;
        u.pm = fm + ((wgid % nig) % gsz); u.pn = (wgid % nig) / gsz;
    }
    __device__ bool next(int i, Unit& u) const {
        const long L = (long)i * G + c; if (L >= nwg) return false;
        tile((int)L, u); u.b = 0; u.A = A + (size_t)u.pm * tstep; u.B = Bt + (size_t)u.pn * tstep; return true;
    }
};
struct BranchOrder {
    StaticOrder base; const char* A3[3]; const char* B3[3];
    __device__ bool next(int i, Unit& u) const {
        if (i >= 3 || base.c >= base.nwg) return false;
        base.tile(base.c, u); u.b = i; u.A = (i == 0 ? A3[0] : i == 1 ? A3[1] : A3[2]) + (size_t)u.pm * base.tstep; u.B = (i == 0 ? B3[0] : i == 1 ? B3[1] : B3[2]) + (size_t)u.pn * base.tstep; return true;
    }
};

template <class Epi, class Sched, bool ALIGN_EPI = false, bool SP2 = false>
__device__ __forceinline__ void gemm_phase(PG8_LAS unsigned char* lds, const Gemm g, const Sched& S, const Epi& E) {
    int tid_ = threadIdx.x; asm volatile("" : "+v"(tid_)); const int tid = tid_, wid = __builtin_amdgcn_readfirstlane(tid >> 6), lane = tid & 63, wr = wid >> 2, wc = wid & 3, fr = lane & 15, fq = lane >> 4;
    const int K = g.K, nt = K / BK;
    unsigned voffA[2];
#pragma unroll
    for (int i = 0; i < 2; ++i) { int R, C; stage_rc(tid * 16 + i * 8192, R, C); voffA[i] = (unsigned)(R * K + C) * 2u; }
    const size_t kstep = (size_t)(BK * 2);
    const size_t hstep = (size_t)HALF * K * 2;
    const unsigned ldsw = (unsigned)wid * 1024u;
    const int aoff = lds_byte(wr * 64 + fr, fq * 8), boff = lds_byte(wc * 32 + fr, fq * 8);
#define PG8_SA(b, h) (((b) * 2 + (h)) * HTB)
#define PG8_SB(b, h) ((4 + (b) * 2 + (h)) * HTB)
#define PG8_STAGE(bufoff, gbase, voff) do { _Pragma("unroll") for (int _i = 0; _i < 2; ++_i) \
        __builtin_amdgcn_global_load_lds((const unsigned*)((const char*)(gbase) + (voff)[_i]), (PG8_LAS unsigned*)(lds + (bufoff) + ldsw + _i * 8192), 16, 0, 0); } while (0)
#define PG8_LDA(dst, b, h) do { _Pragma("unroll") for (int m = 0; m < 4; ++m) _Pragma("unroll") for (int k = 0; k < 2; ++k) dst[m][k] = *(const PG8_LAS bf16x8*)(lds + PG8_SA(b, h) + aoff + m * 2048 + k * 1024); } while (0)
#define PG8_LDB(dst, b, h) do { _Pragma("unroll") for (int n = 0; n < 2; ++n) _Pragma("unroll") for (int k = 0; k < 2; ++k) dst[n][k] = *(const PG8_LAS bf16x8*)(lds + PG8_SB(b, h) + boff + n * 2048 + k * 1024); } while (0)
#define PG8_MMA(ai, bj, At, Bt) do { __builtin_amdgcn_s_setprio(1); _Pragma("unroll") for (int m = 0; m < 4; ++m) _Pragma("unroll") for (int n = 0; n < 2; ++n) _Pragma("unroll") for (int k = 0; k < 2; ++k) \
        acc[ai][bj][m][n] = __builtin_amdgcn_mfma_f32_16x16x32_bf16(Bt[n][k], At[m][k], acc[ai][bj][m][n], 0, 0, 0); __builtin_amdgcn_s_setprio(0); } while (0)
#define PG8_WAIT_V(n) asm volatile("s_waitcnt vmcnt(" #n ")" ::: "memory")
#define PG8_WAIT_L(n) asm volatile("s_waitcnt lgkmcnt(" #n ")" ::: "memory")
#define PG8_BAR __builtin_amdgcn_s_barrier()
#define PG8_SCHED __builtin_amdgcn_sched_barrier(0)
    Unit cur, nxt; int ui = 0;
    if (!S.next(0, cur)) return;
    f32x4 acc[2][2][4][2];
#pragma unroll
    for (int a = 0; a < 2; ++a)
#pragma unroll
        for (int b = 0; b < 2; ++b)
#pragma unroll
            for (int m = 0; m < 4; ++m)
#pragma unroll
                for (int n = 0; n < 2; ++n) acc[a][b][m][n] = (f32x4){0.f, 0.f, 0.f, 0.f};
    bf16x8 At[4][2], B0[2][2], B1[2][2];
    const char* cA = cur.A; const char* cB = cur.B;
    if constexpr (SP2) {
        PG8_STAGE(PG8_SB(0, 0), cB, voffA); PG8_STAGE(PG8_SB(0, 1), cB + hstep, voffA); PG8_STAGE(PG8_SA(0, 0), cA, voffA); PG8_STAGE(PG8_SA(0, 1), cA + hstep, voffA);
        if (wr == 1) PG8_BAR;
        PG8_WAIT_V(2); PG8_BAR;
        PG8_STAGE(PG8_SB(1, 0), cB + kstep, voffA); PG8_STAGE(PG8_SA(1, 0), cA + kstep, voffA); PG8_STAGE(PG8_SB(1, 1), cB + hstep + kstep, voffA);
        PG8_WAIT_V(6); PG8_BAR;
    } else {
        PG8_STAGE(PG8_SB(0, 0), cB, voffA); PG8_STAGE(PG8_SA(0, 0), cA, voffA); PG8_STAGE(PG8_SB(0, 1), cB + hstep, voffA); PG8_STAGE(PG8_SA(0, 1), cA + hstep, voffA);
        if (wr == 1) PG8_BAR;
        PG8_WAIT_V(4); PG8_BAR;
        PG8_STAGE(PG8_SB(1, 0), cB + kstep, voffA); PG8_STAGE(PG8_SA(1, 0), cA + kstep, voffA); PG8_STAGE(PG8_SB(1, 1), cB + hstep + kstep, voffA);
        PG8_WAIT_V(6); PG8_BAR;
    }
    for (;;) {
        const bool has_next = S.next(ui + 1, nxt);
        const char* nA = has_next ? nxt.A : cA; const char* nB = has_next ? nxt.B : cB;
        for (int t = 0; t < nt; t += 2) {
            const bool last = (t == nt - 2);
            const char* a1 = cA + (size_t)(t + 1) * kstep;
            const char* a2 = last ? nA : cA + (size_t)(t + 2) * kstep; const char* b2 = last ? nB : cB + (size_t)(t + 2) * kstep;
            const char* a3 = a2 + kstep; const char* b3 = b2 + kstep;
            if constexpr (SP2) {
            PG8_LDB(B0, 0, 0); PG8_LDB(B1, 0, 1); PG8_SCHED; PG8_LDA(At, 0, 0); PG8_STAGE(PG8_SA(1, 1), a1 + hstep, voffA);
            PG8_WAIT_V(8); PG8_WAIT_L(0); PG8_BAR; PG8_MMA(0, 0, At, B0); PG8_MMA(0, 1, At, B1); PG8_BAR; PG8_SCHED;
            PG8_LDA(At, 0, 1); PG8_STAGE(PG8_SB(0, 0), b2, voffA); PG8_STAGE(PG8_SB(0, 1), b2 + hstep, voffA); PG8_STAGE(PG8_SA(0, 0), a2, voffA);
            PG8_WAIT_V(8); PG8_WAIT_L(0); PG8_BAR; PG8_MMA(1, 0, At, B0); PG8_MMA(1, 1, At, B1); PG8_BAR; PG8_SCHED;
            PG8_LDB(B0, 1, 0); PG8_LDB(B1, 1, 1); PG8_SCHED; PG8_LDA(At, 1, 0); PG8_STAGE(PG8_SA(0, 1), a2 + hstep, voffA);
            PG8_WAIT_V(8); PG8_WAIT_L(0); PG8_BAR; PG8_MMA(0, 0, At, B0); PG8_MMA(0, 1, At, B1); PG8_BAR; PG8_SCHED;
            PG8_LDA(At, 1, 1); PG8_STAGE(PG8_SB(1, 0), b3, voffA); PG8_STAGE(PG8_SB(1, 1), b3 + hstep, voffA); PG8_STAGE(PG8_SA(1, 0), a3, voffA);
            PG8_WAIT_V(8); PG8_WAIT_L(0); PG8_BAR; PG8_MMA(1, 0, At, B0); PG8_MMA(1, 1, At, B1); PG8_BAR; PG8_SCHED;
            } else {
            PG8_LDB(B0, 0, 0); PG8_SCHED; PG8_LDA(At, 0, 0); PG8_STAGE(PG8_SA(1, 1), a1 + hstep, voffA);
            PG8_WAIT_L(8); PG8_BAR; PG8_WAIT_L(0); PG8_MMA(0, 0, At, B0); PG8_BAR; PG8_SCHED;
            PG8_LDB(B1, 0, 1); PG8_STAGE(PG8_SB(0, 0), b2, voffA);
            PG8_BAR; PG8_WAIT_L(0); PG8_MMA(0, 1, At, B1); PG8_BAR;
            PG8_LDA(At, 0, 1); PG8_STAGE(PG8_SA(0, 0), a2, voffA);
            PG8_BAR; PG8_WAIT_L(0); PG8_MMA(1, 0, At, B0); PG8_BAR; PG8_SCHED;
            PG8_STAGE(PG8_SB(0, 1), b2 + hstep, voffA);
            PG8_WAIT_V(6); PG8_BAR; PG8_MMA(1, 1, At, B1); PG8_BAR;
            PG8_LDB(B0, 1, 0); PG8_SCHED; PG8_LDA(At, 1, 0); PG8_STAGE(PG8_SA(0, 1), a2 + hstep, voffA);
            PG8_WAIT_L(8); PG8_BAR; PG8_WAIT_L(0); PG8_MMA(0, 0, At, B0); PG8_BAR; PG8_SCHED;
            PG8_LDB(B1, 1, 1); PG8_STAGE(PG8_SB(1, 0), b3, voffA);
            PG8_BAR; PG8_WAIT_L(0); PG8_MMA(0, 1, At, B1); PG8_BAR;
            PG8_LDA(At, 1, 1); PG8_STAGE(PG8_SA(1, 0), a3, voffA);
            PG8_BAR; PG8_WAIT_L(0); PG8_MMA(1, 0, At, B0); PG8_BAR; PG8_SCHED;
            PG8_STAGE(PG8_SB(1, 1), b3 + hstep, voffA);
            PG8_WAIT_V(6); PG8_BAR; PG8_MMA(1, 1, At, B1); PG8_BAR;
            }
        }
        if constexpr (ALIGN_EPI) { if (wr == 0) PG8_BAR; }
        E(acc, cur, wr, wc, fr, fq);
        if (!has_next) break;
        if (!(Epi::KEEPACC && nxt.b != 0)) {
#pragma unroll
        for (int a = 0; a < 2; ++a)
#pragma unroll
            for (int b = 0; b < 2; ++b)
#pragma unroll
                for (int m = 0; m < 4; ++m)
#pragma unroll
                    for (int n = 0; n < 2; ++n) acc[a][b][m][n] = (f32x4){0.f, 0.f, 0.f, 0.f};
        }
        cur = nxt; cA = nA; cB = nB; ++ui;
        if constexpr (ALIGN_EPI) { if (wr == 1) PG8_BAR; }
    }
    PG8_WAIT_V(0);
    if constexpr (!ALIGN_EPI) { if (wr == 0) PG8_BAR; }
    PG8_BAR;
#undef PG8_SA
#undef PG8_SB
#undef PG8_STAGE
#undef PG8_LDA
#undef PG8_LDB
#undef PG8_MMA
#undef PG8_WAIT_V
#undef PG8_WAIT_L
#undef PG8_BAR
#undef PG8_SCHED
}
}

typedef f32x4 Acc[2][2][4][2];

struct EpiSwiglu {
    static constexpr bool KEEPACC = false;
    bf16_t* act; const float* ssq; const LAS float* rl; int pm0;
    template <int NAI, int NM> __device__ __forceinline__ void run(const Acc& acc, int rowbase, int pn, int wc, int fr, int fq) const {
        const bool inl = (NAI == 2) && ((rowbase >> 8) == pm0);
#pragma unroll
        for (int ai = 0; ai < NAI; ++ai)
#pragma unroll
            for (int m = 0; m < NM; ++m) {
                const int row = rowbase + 128 * ai + 16 * m + fr;
                const float rs = inl ? rl[row & 255] : row_rstd(ssq, row);
                bf16_t* rp = act + (size_t)row * DFF + 128 * pn + 32 * wc + 8 * fq;
                unsigned w[4];
#pragma unroll
                for (int n = 0; n < 2; ++n) {
                    const f32x4 g = acc[ai][0][m][n] * rs, u = acc[ai][1][m][n] * rs; float v[4];
#pragma unroll
                    for (int j = 0; j < 4; ++j) v[j] = g[j] * __builtin_amdgcn_rcpf(1.f + __expf(-g[j])) * u[j];
                    w[2 * n] = pk2(v[0], v[1]); w[2 * n + 1] = pk2(v[2], v[3]);
                }
                *(u32x4*)rp = (u32x4){w[0], w[1], w[2], w[3]};
            }
    }
    __device__ __forceinline__ void operator()(const Acc& acc, const pg8::Unit& u, int wr, int wc, int fr, int fq) const { run<2, 4>(acc, u.pm * 256 + wr * 64, u.pn, wc, fr, fq); }
};

struct EpiResid {
    static constexpr bool KEEPACC = false;
    bf16_t* hb; float* ssq; float alpha;
    template <int NAI, int NM> __device__ __forceinline__ void run(const Acc& acc, int rowbase, int pn, int wc, int fr, int fq) const {
        const int ln = fr + 16 * fq;
#pragma unroll
        for (int ai = 0; ai < NAI; ++ai)
#pragma unroll
            for (int m = 0; m < NM; ++m) {
                const int row = rowbase + 128 * ai + 16 * m + fr; const int col0 = 256 * pn + 32 * wc + 8 * fq;
                bf16_t* np = hb + (size_t)row * DM + col0;
                u32x4 old[2];
#pragma unroll
                for (int bj = 0; bj < 2; ++bj) old[bj] = *(const u32x4*)(np + 128 * bj);
                float ss = 0.f;
#pragma unroll
                for (int bj = 0; bj < 2; ++bj) { const f32x4 a0 = acc[ai][bj][m][0], a1 = acc[ai][bj][m][1]; const u32x4 o = old[bj];
                    const unsigned w0 = pk2(bflo(o.x) + alpha * a0[0], bfhi(o.x) + alpha * a0[1]), w1 = pk2(bflo(o.y) + alpha * a0[2], bfhi(o.y) + alpha * a0[3]);
                    const unsigned w2 = pk2(bflo(o.z) + alpha * a1[0], bfhi(o.z) + alpha * a1[1]), w3 = pk2(bflo(o.w) + alpha * a1[2], bfhi(o.w) + alpha * a1[3]);
                    const float r0 = bflo(w0), r1 = bfhi(w0), r2 = bflo(w1), r3 = bfhi(w1), r4 = bflo(w2), r5 = bfhi(w2), r6 = bflo(w3), r7 = bfhi(w3);
                    ss += (r0 * r0 + r1 * r1 + r2 * r2 + r3 * r3) + (r4 * r4 + r5 * r5 + r6 * r6 + r7 * r7);
                    *(u32x4*)(np + 128 * bj) = (u32x4){w0, w1, w2, w3}; }
                ss += shx(ss, 16, ln); ss += shx(ss, 32, ln);
                if (fq == 0) ssq[(size_t)row * 16 + 4 * pn + wc] = ss;
            }
    }
    __device__ __forceinline__ void operator()(const Acc& acc, const pg8::Unit& u, int wr, int wc, int fr, int fq) const { run<2, 4>(acc, u.pm * 256 + wr * 64, u.pn, wc, fr, fq); }
};

struct EpiBranch {
    static constexpr bool KEEPACC = true;
    const bf16_t* gates; bf16_t* mixed;
    template <int NAI, int NM> __device__ __forceinline__ void run(const Acc& acc, int rowbase, int pn, int wc, int fr, int fq, int b = 0) const {
#pragma unroll
        for (int ai = 0; ai < NAI; ++ai)
#pragma unroll
            for (int m = 0; m < NM; ++m) {
                const int row = rowbase + 128 * ai + 16 * m + fr; const int col0 = 256 * pn + 32 * wc + 8 * fq;
                const unsigned char* gp = (const unsigned char*)gates + (size_t)row * 3072 + b * 1024 + col0; bf16_t* mp = mixed + (size_t)row * DM + col0;
#pragma unroll
                for (int bj = 0; bj < 2; ++bj) {
                    const u32x2 g2 = *(const u32x2*)(gp + 128 * bj); unsigned w[4];
                    u32x4 o = {0u, 0u, 0u, 0u}; if (b > 0) o = *(const u32x4*)(mp + 128 * bj);
#pragma unroll
                    for (int n = 0; n < 2; ++n) { const unsigned gg = n == 0 ? g2.x : g2.y; const f32x4 a = acc[ai][bj][m][n];
                        float v0 = (float)(gg & 255u) * (1.f / 255.f) * a[0], v1 = (float)((gg >> 8) & 255u) * (1.f / 255.f) * a[1], v2 = (float)((gg >> 16) & 255u) * (1.f / 255.f) * a[2], v3 = (float)(gg >> 24) * (1.f / 255.f) * a[3];
                        const unsigned ox = n == 0 ? o.x : o.z, oy = n == 0 ? o.y : o.w;
                        if (b > 0) { v0 += bflo(ox); v1 += bfhi(ox); v2 += bflo(oy); v3 += bfhi(oy); }
                        w[2 * n] = pk2(v0, v1); w[2 * n + 1] = pk2(v2, v3); }
                    *(u32x4*)(mp + 128 * bj) = (u32x4){w[0], w[1], w[2], w[3]};
                }
            }
    }
    __device__ __forceinline__ void operator()(Acc& acc, const pg8::Unit& u, int wr, int wc, int fr, int fq) const {
        const int b = u.b;
#pragma unroll
        for (int ai = 0; ai < 2; ++ai)
#pragma unroll
            for (int m = 0; m < 4; ++m) {
                const int row = u.pm * 256 + wr * 64 + 128 * ai + 16 * m + fr; const int col0 = 256 * u.pn + 32 * wc + 8 * fq;
                const unsigned char* gp = (const unsigned char*)gates + (size_t)row * 3072 + b * 1024 + col0; bf16_t* mp = mixed + (size_t)row * DM + col0;
#pragma unroll
                for (int bj = 0; bj < 2; ++bj) {
                    const u32x2 g2 = *(const u32x2*)(gp + 128 * bj);
                    u32x2 gn2 = {0u, 0u}; if (b < 2) gn2 = *(const u32x2*)(gp + 1024 + 128 * bj);
                    unsigned w[4];
#pragma unroll
                    for (int n = 0; n < 2; ++n) {
                        const unsigned gg = n == 0 ? g2.x : g2.y, gn = n == 0 ? gn2.x : gn2.y;
                        f32x4 a = acc[ai][bj][m][n];
#pragma unroll
                        for (int j = 0; j < 4; ++j) {
                            float g = (float)((gg >> (8 * j)) & 255u) * (1.f / 255.f);
                            if (b > 0) g = fmaxf(g, 9.5367431640625e-07f);
                            if (b < 2) { const float gnx = fmaxf((float)((gn >> (8 * j)) & 255u) * (1.f / 255.f), 9.5367431640625e-07f); g *= __builtin_amdgcn_rcpf(gnx); }
                            a[j] *= g;
                        }
                        acc[ai][bj][m][n] = a;
                        w[2 * n] = pk2(a[0], a[1]); w[2 * n + 1] = pk2(a[2], a[3]);
                    }
                    if (b == 2) *(u32x4*)(mp + 128 * bj) = (u32x4){w[0], w[1], w[2], w[3]};
                }
            }
    }
};

__device__ __forceinline__ int vslot16(int k) { return 8 * ((k >> 2) & 1) + 4 * (k >> 3) + (k & 3); }

struct EpiWin {
    static constexpr bool KEEPACC = false;
    bf16_t* qk; bf16_t* vt; bf16_t* gates; const float* tab; const float* qn; const float* kn; const float* ssq; const LAS float* rl; int pm0;
    template <int NAI, int NM> __device__ __forceinline__ void run(const Acc& acc, int rowbase, int pn, int wc, int fr, int fq) const {
        const bool inl = (NAI == 2) && ((rowbase >> 8) == pm0);
        if (pn >= 12) {
#pragma unroll
            for (int ai = 0; ai < NAI; ++ai)
#pragma unroll
                for (int m = 0; m < NM; ++m) {
                    const int row = rowbase + 128 * ai + 16 * m + fr;
                    const float rs = inl ? rl[row & 255] : row_rstd(ssq, row);
                    unsigned char* rp = (unsigned char*)gates + (size_t)row * 3072 + 256 * (pn - 12) + 32 * wc + 8 * fq;
#pragma unroll
                    for (int bj = 0; bj < 2; ++bj) { unsigned w2[2];
#pragma unroll
                        for (int n = 0; n < 2; ++n) { const f32x4 a = acc[ai][bj][m][n]; unsigned w = 0u;
#pragma unroll
                            for (int j = 0; j < 4; ++j) { const float g = __builtin_amdgcn_rcpf(1.f + __expf(-a[j] * rs)); w |= (unsigned)(int)(g * 255.f + 0.5f) << (8 * j); }
                            w2[n] = w; }
                        *(u32x2*)(rp + 128 * bj) = (u32x2){w2[0], w2[1]}; }
                }
            return;
        }
        int kind, colbase = 0, hv = 0; unsigned scale_bits = 0x3f800000u; const float* gain = nullptr;
        if (pn < 2) { kind = 0; colbase = QA_OFF + (4 * pn + wc) * 64; scale_bits = 0x3e38aa3bu; }
        else if (pn == 2) { if (wc < 2) { kind = 0; colbase = KA_OFF + wc * 64; } else { kind = 2; colbase = KC_OFF + (wc - 2) * 64; gain = kn; } }
        else if (pn == 3) { kind = 3; hv = wc < 2 ? wc : 8 + wc; }
        else if (pn < 6) { kind = 1; colbase = QB_OFF + (4 * (pn - 4) + wc) * 64; scale_bits = 0x3e38aa3bu; }
        else if (pn < 8) { kind = 1; colbase = KB_OFF + (4 * (pn - 6) + wc) * 64; }
        else if (pn < 10) { kind = 3; hv = 2 + 4 * (pn - 8) + wc; }
        else { kind = 2; colbase = QC_OFF + (4 * (pn - 10) + wc) * 64; gain = qn; scale_bits = 0x3e38aa3bu; }
        const float scale = __uint_as_float(scale_bits);
        const float* tabl = tab; asm volatile("" : "+s"(tabl));
        const float* cosA = tabl; const float* sinA = tabl + 4112 * 32;
        const float* axr_c = tabl + 2 * 4112 * 32; const float* axr_s = axr_c + 65 * 16; const float* axc_c = axr_s + 65 * 16; const float* axc_s = axc_c + 64 * 16;
#pragma unroll
        for (int ai = 0; ai < NAI; ++ai)
#pragma unroll
            for (int m = 0; m < NM; ++m) {
                const int row = rowbase + 128 * ai + 16 * m + fr;
                int b, p, grow, gcol, slot;
                if (row < NREAL) { b = row >> 12; const int s = row & 4095; p = s + 16; grow = s >> 6; gcol = s & 63; slot = (s & ~15) + vslot16(s & 15); }
                else { const int i = (row - NREAL) & 15; b = (row - NREAL) >> 4; p = i; grow = -1; gcol = i; slot = SEQ + vslot16(i); }
                const float rs = inl ? rl[row & 255] : row_rstd(ssq, row);
                float x[2][2][4];
#pragma unroll
                for (int bj = 0; bj < 2; ++bj)
#pragma unroll
                    for (int n = 0; n < 2; ++n)
#pragma unroll
                        for (int j = 0; j < 4; ++j) x[bj][n][j] = acc[ai][bj][m][n][j] * rs;
                if (kind == 3) {
                    const int qi = fr & 3, qq = fr >> 2;
                    const int slot4 = (slot & ~15) + 8 * (qq & 1) + 4 * (qq >> 1);
                    bf16_t* vp = vt + ((size_t)(b * NVH + hv) * 64) * VL + slot4;
#pragma unroll
                    for (int bj = 0; bj < 2; ++bj)
#pragma unroll
                        for (int n = 0; n < 2; ++n) {
                            int v0 = (int)(pk2(x[bj][n][0], 0.f) & 0xffffu), v1 = (int)(pk2(x[bj][n][1], 0.f) & 0xffffu), v2 = (int)(pk2(x[bj][n][2], 0.f) & 0xffffu), v3 = (int)(pk2(x[bj][n][3], 0.f) & 0xffffu);
                            { const int s01 = (qi & 1) ? v0 : v1, s23 = (qi & 1) ? v2 : v3;
                              const int r01 = __builtin_amdgcn_mov_dpp(s01, 0xB1, 0xf, 0xf, true), r23 = __builtin_amdgcn_mov_dpp(s23, 0xB1, 0xf, 0xf, true);
                              if (qi & 1) { v0 = r01; v2 = r23; } else { v1 = r01; v3 = r23; } }
                            { const int s02 = (qi & 2) ? v0 : v2, s13 = (qi & 2) ? v1 : v3;
                              const int r02 = __builtin_amdgcn_mov_dpp(s02, 0x4E, 0xf, 0xf, true), r13 = __builtin_amdgcn_mov_dpp(s13, 0x4E, 0xf, 0xf, true);
                              if (qi & 2) { v0 = r02; v1 = r13; } else { v2 = r02; v3 = r13; } }
                            *(u32x2*)(vp + (size_t)(32 * bj + 16 * n + 4 * fq + qi) * VL) = (u32x2){(unsigned)v0 | ((unsigned)v1 << 16), (unsigned)v2 | ((unsigned)v3 << 16)};
                        }
                    continue;
                }
                if (kind == 0) {
#pragma unroll
                    for (int n = 0; n < 2; ++n) {
                        const f32x4 c = *(const f32x4*)(cosA + p * 32 + 8 * fq + 4 * n), s = *(const f32x4*)(sinA + p * 32 + 8 * fq + 4 * n);
#pragma unroll
                        for (int j = 0; j < 4; ++j) { const float x1 = x[0][n][j], x2 = x[1][n][j]; x[0][n][j] = x1 * c[j] - x2 * s[j]; x[1][n][j] = x2 * c[j] + x1 * s[j]; }
                    }
                } else if (kind == 2) {
                    float ss = 0.f;
#pragma unroll
                    for (int bj = 0; bj < 2; ++bj)
#pragma unroll
                        for (int n = 0; n < 2; ++n)
#pragma unroll
                            for (int j = 0; j < 4; ++j) ss += x[bj][n][j] * x[bj][n][j];
                    { const int ln = fr + 16 * fq; ss += shx(ss, 16, ln); ss += shx(ss, 32, ln); }
                    const float rinv = rsqrtf(ss * (1.f / 64.f) + EPS);
#pragma unroll
                    for (int bj = 0; bj < 2; ++bj)
#pragma unroll
                        for (int n = 0; n < 2; ++n) { const f32x4 gg = *(const f32x4*)(gain + 32 * bj + 16 * n + 4 * fq);
#pragma unroll
                            for (int j = 0; j < 4; ++j) x[bj][n][j] = x[bj][n][j] * rinv * gg[j]; }
#pragma unroll
                    for (int bj = 0; bj < 2; ++bj) {
                        const float* tc = bj == 0 ? axr_c + (grow + 1) * 16 : axc_c + gcol * 16; const float* ts = bj == 0 ? axr_s + (grow + 1) * 16 : axc_s + gcol * 16;
                        const f32x4 c = *(const f32x4*)(tc + 4 * fq), s = *(const f32x4*)(ts + 4 * fq);
#pragma unroll
                        for (int j = 0; j < 4; ++j) { const float x1 = x[bj][0][j], x2 = x[bj][1][j]; x[bj][0][j] = x1 * c[j] - x2 * s[j]; x[bj][1][j] = x2 * c[j] + x1 * s[j]; }
                    }
                }
                if (kind == 2) {
                    bf16_t* rp = qk + (size_t)row * QKP + colbase + 4 * fq;
#pragma unroll
                    for (int bj = 0; bj < 2; ++bj)
#pragma unroll
                        for (int n = 0; n < 2; ++n)
                            *(u32x2*)(rp + 32 * bj + 16 * n) = (u32x2){pk2(x[bj][n][0] * scale, x[bj][n][1] * scale), pk2(x[bj][n][2] * scale, x[bj][n][3] * scale)};
                } else {
                    bf16_t* rp = qk + (size_t)row * QKP + colbase + 8 * fq;
#pragma unroll
                    for (int bj = 0; bj < 2; ++bj)
                        *(u32x4*)(rp + 32 * bj) = (u32x4){pk2(x[bj][0][0] * scale, x[bj][0][1] * scale), pk2(x[bj][0][2] * scale, x[bj][0][3] * scale), pk2(x[bj][1][0] * scale, x[bj][1][1] * scale), pk2(x[bj][1][2] * scale, x[bj][1][3] * scale)};
                }
            }
    }
    __device__ __forceinline__ void operator()(const Acc& acc, const pg8::Unit& u, int wr, int wc, int fr, int fq) const { run<2, 4>(acc, u.pm * 256 + wr * 64, u.pn, wc, fr, fq); }
};

template <class Epi, bool BR = false> __device__ __forceinline__ void meta_job(LAS unsigned char* lds, const bf16_t* A, const bf16_t* Bt, int K, int pn, int wcj, const Epi& E, int b = 0) {
    int tid_ = threadIdx.x; asm volatile("" : "+v"(tid_));
    const int tid = tid_, wid = __builtin_amdgcn_readfirstlane(tid >> 6), lane = tid & 63, fr = lane & 15, fq = lane >> 4;
    f32x4 acc[2][4][2];
#pragma unroll
    for (int b = 0; b < 2; ++b)
#pragma unroll
        for (int m = 0; m < 4; ++m)
#pragma unroll
            for (int n = 0; n < 2; ++n) acc[b][m][n] = (f32x4){0.f, 0.f, 0.f, 0.f};
    const int kper = K >> 3, kbeg = wid * kper;
    const bf16_t* ap = A + (size_t)(MROW0 + fr) * K + 8 * fq + kbeg;
    const bf16_t* bp = Bt + (size_t)(256 * pn + 32 * wcj + fr) * K + 8 * fq + kbeg;
#pragma unroll 4
    for (int k0 = 0; k0 < kper; k0 += 32) {
        bf16x8 a[4], w[2][2];
#pragma unroll
        for (int m = 0; m < 4; ++m) a[m] = *(const bf16x8*)(ap + (size_t)(16 * m) * K + k0);
#pragma unroll
        for (int bj = 0; bj < 2; ++bj)
#pragma unroll
            for (int n = 0; n < 2; ++n) w[bj][n] = *(const bf16x8*)(bp + (size_t)(128 * bj + 16 * n) * K + k0);
#pragma unroll
        for (int bj = 0; bj < 2; ++bj)
#pragma unroll
            for (int m = 0; m < 4; ++m)
#pragma unroll
                for (int n = 0; n < 2; ++n) acc[bj][m][n] = __builtin_amdgcn_mfma_f32_16x16x32_bf16(w[bj][n], a[m], acc[bj][m][n], 0, 0, 0);
    }
    LAS f32x4* part = (LAS f32x4*)lds;
#pragma unroll
    for (int bj = 0; bj < 2; ++bj)
#pragma unroll
        for (int m = 0; m < 4; ++m)
#pragma unroll
            for (int n = 0; n < 2; ++n) part[(wid * 16 + (bj * 4 + m) * 2 + n) * 64 + lane] = acc[bj][m][n];
    __syncthreads();
    if (wid < 2) {
        Acc r;
#pragma unroll
        for (int a = 0; a < 2; ++a)
#pragma unroll
            for (int b = 0; b < 2; ++b)
#pragma unroll
                for (int m = 0; m < 4; ++m)
#pragma unroll
                    for (int n = 0; n < 2; ++n) r[a][b][m][n] = (f32x4){0.f, 0.f, 0.f, 0.f};
#pragma unroll
        for (int bj = 0; bj < 2; ++bj)
#pragma unroll
            for (int mm = 0; mm < 2; ++mm)
#pragma unroll
                for (int n = 0; n < 2; ++n) {
                    f32x4 sum = (f32x4){0.f, 0.f, 0.f, 0.f};
                    for (int w8 = 0; w8 < 8; ++w8) sum += part[(w8 * 16 + (bj * 4 + 2 * wid + mm) * 2 + n) * 64 + lane];
                    r[0][bj][mm][n] = sum;
                }
        if constexpr (BR) E.template run<1, 2>(r, MROW0 + 32 * wid, pn, wcj, fr, fq, b); else E.template run<1, 2>(r, MROW0 + 32 * wid, pn, wcj, fr, fq);
    }
    __syncthreads();
}

__device__ __forceinline__ void meta_publish(unsigned* cnt) {
    asm volatile("s_waitcnt vmcnt(0)" ::: "memory");
    __syncthreads();
    if (threadIdx.x == 0) { __builtin_amdgcn_fence(__ATOMIC_RELEASE, "agent"); asm volatile("s_waitcnt vmcnt(0)" ::: "memory"); (void)xb_add(cnt, 1u); }
}
__device__ __forceinline__ void meta_wait(unsigned* cnt, unsigned need) {
    if (threadIdx.x == 0) { unsigned sp = 0u; while (xb_ld(cnt) < need) { __builtin_amdgcn_s_sleep(2); if (++sp > (1u << 22)) break; }
        __builtin_amdgcn_fence(__ATOMIC_ACQUIRE, "agent"); asm volatile("s_waitcnt vmcnt(0)" ::: "memory"); }
    __syncthreads();
}
template <class Epi, bool ALIGN, bool META = true> __device__ __forceinline__ void run_gemm(LAS unsigned char* lds, const bf16_t* A, const bf16_t* Bt, int N, int K, const Epi& E, unsigned* publish = nullptr) {
    const int G = gridDim.x, c = blockIdx.x, njobs = (N / 256) * 4;
    int q = G - 1 - c; asm volatile("" : "+s"(q));
    if (META && q < njobs) { meta_job<Epi>(lds, A, Bt, K, q >> 2, q & 3, E); if (publish) meta_publish(publish); }
    pg8::Gemm g{A, Bt, NREAL, N, K}; pg8::StaticOrder S; S.init(NREAL, N, G, c, A, Bt, K);
    pg8::gemm_phase<Epi, pg8::StaticOrder, ALIGN, true>(lds, g, S, E);
}

__device__ __forceinline__ void fill_rstd(LAS unsigned char* lds, const float* ssq, int pm0) {
    const int t = ltid();
    if (t < 256) ((LAS float*)(lds + LDS_RSTD))[t] = row_rstd(ssq, 256 * pm0 + t);
    __syncthreads();
}
__device__ __forceinline__ int first_panel(int N) {
    pg8::StaticOrder S; S.init(NREAL, N, gridDim.x, blockIdx.x, nullptr, nullptr, DM); pg8::Unit u; u.pm = -1; u.pn = 0;
    if ((int)blockIdx.x < S.nwg) S.tile((int)blockIdx.x, u);
    return u.pm;
}

__device__ __forceinline__ void run_branch(LAS unsigned char* lds, const bf16_t* oa, const bf16_t* ob, const bf16_t* oc, const bf16_t* Wb, const EpiBranch& E) {
    const int G = gridDim.x, c = blockIdx.x;
    int q = G - 1 - c; asm volatile("" : "+s"(q));
    (void)q;
    pg8::Gemm g{oa, Wb, NREAL, DM, 512}; pg8::BranchOrder S; S.base.init(NREAL, DM, G, c, oa, Wb, 512);
    S.A3[0] = (const char*)oa; S.A3[1] = (const char*)ob; S.A3[2] = (const char*)oc;
    S.B3[0] = (const char*)Wb; S.B3[1] = (const char*)(Wb + (size_t)DM * 512); S.B3[2] = (const char*)(Wb + (size_t)2 * DM * 512);
    pg8::gemm_phase<EpiBranch, pg8::BranchOrder, true, true>(lds, g, S, E);
}

__device__ __forceinline__ int perm32(int rho) { const int n = rho >> 4, i = rho & 15; return 8 * (i >> 2) + 4 * n + (i & 3); }
__device__ __forceinline__ bool perm_group(int kind, int sg) {
    if (kind != 2) return true;
    const int pn = sg >> 3, wc = sg & 3;
    if (pn >= 12) return true;
    if (pn < 2) return true;
    if (pn == 2) return wc < 2;
    if (pn >= 4 && pn < 8) return true;
    return false;
}
__device__ __forceinline__ int map_cols(int kind, int sg) {
    if (kind == 0) return 32 * sg;
    const int pn = sg >> 3, w = sg & 7;
    if (kind == 1) return w < 4 ? 128 * pn + 32 * w : DFF + 128 * pn + 32 * (w - 4);
    if (pn >= 12) return 32 * sg;
    const int bj = w >> 2, wc = w & 3; int base;
    if (pn < 2) base = 0 + (4 * pn + wc) * 64;
    else if (pn == 2) base = wc < 2 ? 512 + wc * 64 : 2816 + (wc - 2) * 64;
    else if (pn == 3) base = wc < 2 ? 640 + wc * 64 : 2944 + (wc - 2) * 64;
    else if (pn < 6) base = 768 + (4 * (pn - 4) + wc) * 64;
    else if (pn < 8) base = 1280 + (4 * (pn - 6) + wc) * 64;
    else if (pn < 10) base = 1792 + (4 * (pn - 8) + wc) * 64;
    else base = 2304 + (4 * (pn - 10) + wc) * 64;
    return base + 32 * bj;
}
__device__ __forceinline__ void conv_matrix(const float* W, int K, int ldw, int nslots, int kind, bf16_t* WT, const float* gain, LAS float* scr, int gw, int NGW, int lane) {
    asm volatile("" : "+v"(lane)); const int nsg = nslots / 32, nitems = (K / 64) * nsg;
    for (int it = gw; it < nitems; it += NGW) {
        const int kb = it / nsg, sg = it % nsg, k0 = 64 * kb, c0 = map_cols(kind, sg); const bool pg = perm_group(kind, sg);
        { const int r8 = lane >> 3, c4 = lane & 7; f32x4 v[8]; float gk[8];
#pragma unroll
          for (int i = 0; i < 8; ++i) { const int kk = 8 * i + r8; v[i] = *(const f32x4*)(W + (size_t)(k0 + kk) * ldw + c0 + 4 * c4); gk[i] = gain ? gain[k0 + kk] : 1.f; }
#pragma unroll
          for (int i = 0; i < 8; ++i) { const int kk = 8 * i + r8; LAS float* d = scr + kk * 33 + 4 * c4; d[0] = v[i].x * gk[i]; d[1] = v[i].y * gk[i]; d[2] = v[i].z * gk[i]; d[3] = v[i].w * gk[i]; } }
        asm volatile("s_waitcnt lgkmcnt(0)" ::: "memory");
        const int c = lane & 7;
#pragma unroll
        for (int j = 0; j < 4; ++j) { const int n = (lane >> 3) + 8 * j; const LAS float* s = scr + (8 * c) * 33 + (pg ? perm32(n) : n);
            u32x4 o; o.x = pk2(s[0 * 33], s[1 * 33]); o.y = pk2(s[2 * 33], s[3 * 33]); o.z = pk2(s[4 * 33], s[5 * 33]); o.w = pk2(s[6 * 33], s[7 * 33]);
            *(u32x4*)(WT + (size_t)(32 * sg + n) * K + k0 + 8 * c) = o; }
        asm volatile("s_waitcnt lgkmcnt(0)" ::: "memory");
    }
}

__device__ __forceinline__ void init_rows(const Params& P, bf16_t* hb, float* ssq0, int gw, int NGW, int lane) {
    for (int r0 = gw; r0 < NROWS; r0 += 2 * NGW) {
        f32x4 v[2][4];
#pragma unroll
        for (int u = 0; u < 2; ++u) { const int r = min(r0 + u * NGW, NROWS - 1);
            const float* sp = r < NREAL ? P.x + (size_t)r * DM : P.meta + (size_t)((r - NREAL) & 15) * DM;
#pragma unroll
            for (int j = 0; j < 4; ++j) v[u][j] = *(const f32x4*)(sp + 4 * (lane + 64 * j)); }
#pragma unroll
        for (int u = 0; u < 2; ++u) { const int r = r0 + u * NGW;
            if (r < NROWS) {
                float ss = 0.f;
#pragma unroll
                for (int j = 0; j < 4; ++j) { const unsigned w0 = pk2(v[u][j].x, v[u][j].y), w1 = pk2(v[u][j].z, v[u][j].w);
                    const float q0 = bflo(w0), q1 = bfhi(w0), q2 = bflo(w1), q3 = bfhi(w1); ss += q0 * q0 + q1 * q1 + q2 * q2 + q3 * q3;
                    *(u32x2*)(hb + (size_t)r * DM + 4 * (lane + 64 * j)) = (u32x2){w0, w1}; }
                ss = wave_sum(ss, lane);
                if (lane < 16) ssq0[(size_t)r * 16 + lane] = lane == 0 ? ss : 0.f; } }
    }
}

constexpr int ATT_NUNITS = 512 + 512 + 512;
constexpr int LDS_KV = 0;
constexpr int LDS_MRG = 32768;
constexpr int LDS_RPB = 104448 + 512;
constexpr int LDS_CTLW = 131072;

struct AttState { f32x16 o0, o1, negm; float mref, lrun; bool first; };

template <int MIXER, bool META> __device__ __forceinline__ void att_tile(AttState& S, const LAS unsigned char* kb, const bf16x8 (&qf)[4], int r32, int hh, int mb, int cs, const LAS float* bb) {
    const LAS unsigned char* vb = kb + 8192;
    f32x16 s0, s1;
    bf16x8 kf0[4], kf1[4];
#pragma unroll
    for (int dc = 0; dc < 4; ++dc) {
        kf0[dc] = *(const LAS bf16x8*)(kb + (2 * dc + hh) * 1024 + r32 * 16);
        if (!META) kf1[dc] = *(const LAS bf16x8*)(kb + (2 * dc + hh) * 1024 + (32 + r32) * 16);
    }
    __builtin_amdgcn_sched_barrier(0);
#pragma unroll
    for (int dc = 0; dc < 4; ++dc) {
        s0 = __builtin_amdgcn_mfma_f32_32x32x16_bf16(kf0[dc], qf[dc], dc == 0 ? S.negm : s0, 0, 0, 0);
        if (!META) s1 = __builtin_amdgcn_mfma_f32_32x32x16_bf16(kf1[dc], qf[dc], dc == 0 ? S.negm : s1, 0, 0, 0);
    }
    bf16x8 vf0[4], vf1[4];
#pragma unroll
    for (int s = 0; s < (META ? 1 : 4); ++s) {
        vf0[s] = *(const LAS bf16x8*)(vb + (2 * s + hh) * 1024 + r32 * 16);
        vf1[s] = *(const LAS bf16x8*)(vb + (2 * s + hh) * 1024 + (32 + r32) * 16);
    }
    __builtin_amdgcn_sched_barrier(0);
    if (META) {
#pragma unroll
        for (int i = 8; i < 16; ++i) s0[i] = -1e30f;
    } else if (MIXER == 0) {
#pragma unroll
        for (int i = 0; i < 16; ++i) { const int d0 = mb + (i & 3) + 8 * (i >> 2), d1 = d0 + 32;
            if (d0 > 128 || d0 < -128) s0[i] = -1e30f;
            if (d1 > 128 || d1 < -128) s1[i] = -1e30f; }
    } else if (MIXER == 1) {
#pragma unroll
        for (int i = 0; i < 16; ++i) { const int kq = (i & 3) + 8 * (i >> 2); const int c0 = mb + kq, c1 = c0 + 32;
            const float b0 = bb[kq], b1 = bb[kq + 32];
            s0[i] = (c0 >= cs && c0 < cs + 16) ? s0[i] + b0 : -1e30f;
            s1[i] = (c1 >= cs && c1 < cs + 16) ? s1[i] + b1 : -1e30f; }
    }
    float mt;
    if (META) { mt = fmaxf(fmaxf(s0[0], s0[1]), s0[2]); mt = fmaxf(fmaxf(mt, s0[3]), s0[4]); mt = fmaxf(fmaxf(mt, s0[5]), fmaxf(s0[6], s0[7])); }
    else {
        float a = fmaxf(fmaxf(s0[0], s0[1]), s1[0]), b = fmaxf(fmaxf(s0[2], s0[3]), s1[1]); a = fmaxf(fmaxf(a, s1[2]), s1[3]);
#pragma unroll
        for (int r = 4; r < 16; r += 4) { a = fmaxf(fmaxf(a, s0[r]), s0[r + 1]); b = fmaxf(fmaxf(b, s0[r + 2]), s0[r + 3]); a = fmaxf(fmaxf(a, s1[r]), s1[r + 1]); b = fmaxf(fmaxf(b, s1[r + 2]), s1[r + 3]); }
        mt = fmaxf(a, b);
    }
    { auto rr = __builtin_amdgcn_permlane32_swap(__float_as_uint(mt), __float_as_uint(mt), false, false); mt = fmaxf(__uint_as_float(rr[0]), __uint_as_float(rr[1])); }
    if (S.first || __any(mt > 8.f)) {
        const float dl = S.first ? mt : fmaxf(mt, 0.f);
        S.first = false;
        S.mref += dl;
#pragma unroll
        for (int i = 0; i < 16; ++i) { s0[i] -= dl; if (!META) s1[i] -= dl; S.negm[i] = -S.mref; }
        const float f = __builtin_amdgcn_exp2f(-dl);
        S.lrun *= f;
#pragma unroll
        for (int i = 0; i < 16; ++i) { S.o0[i] *= f; S.o1[i] *= f; }
    }
    float psum = 0.f;
    if (META) {
#pragma unroll
        for (int i = 0; i < 8; ++i) { s0[i] = __builtin_amdgcn_exp2f(s0[i]); psum += s0[i]; }
#pragma unroll
        for (int i = 8; i < 16; ++i) s0[i] = 0.f;
    } else {
        float p1 = 0.f;
#pragma unroll
        for (int i = 0; i < 16; ++i) { s0[i] = __builtin_amdgcn_exp2f(s0[i]); s1[i] = __builtin_amdgcn_exp2f(s1[i]); psum += s0[i]; p1 += s1[i]; }
        psum += p1;
    }
    S.lrun += psum;
#pragma unroll
    for (int s = 0; s < (META ? 1 : 4); ++s) {
        u32x4 w;
        if (s == 0) w = (u32x4){pk2(s0[0], s0[1]), pk2(s0[2], s0[3]), pk2(s0[4], s0[5]), pk2(s0[6], s0[7])};
        else if (s == 1) w = (u32x4){pk2(s0[8], s0[9]), pk2(s0[10], s0[11]), pk2(s0[12], s0[13]), pk2(s0[14], s0[15])};
        else if (s == 2) w = (u32x4){pk2(s1[0], s1[1]), pk2(s1[2], s1[3]), pk2(s1[4], s1[5]), pk2(s1[6], s1[7])};
        else w = (u32x4){pk2(s1[8], s1[9]), pk2(s1[10], s1[11]), pk2(s1[12], s1[13]), pk2(s1[14], s1[15])};
        const bf16x8 pf = __builtin_bit_cast(bf16x8, w);
        S.o0 = __builtin_amdgcn_mfma_f32_32x32x16_bf16(vf0[s], pf, S.o0, 0, 0, 0);
        S.o1 = __builtin_amdgcn_mfma_f32_32x32x16_bf16(vf1[s], pf, S.o1, 0, 0, 0);
    }
}

template <int MIXER> __device__ __forceinline__ void attn_unit(LAS unsigned char* lds, int type, int b, int hd, int qblk, const bf16_t* qk, const bf16_t* vt, bf16_t* obuf, const float* sink, const float* rpb) {
    int tid_ = threadIdx.x; asm volatile("" : "+v"(tid_));
    const int tid = tid_, wid = __builtin_amdgcn_readfirstlane(tid >> 6), lane = tid & 63, r32 = lane & 31, hh = lane >> 5;
    LAS float* rpbl = (LAS float*)(lds + LDS_RPB);
    const bool is_meta = (type == 0 || type == 4 || type == 5);
    const int ks = wid & 3;
    int koff, hv;
    if (MIXER == 0) { const int kvh = is_meta ? hd : (hd >> 2); koff = KA_OFF + kvh * 64; hv = kvh; }
    else if (MIXER == 1) { koff = KB_OFF + hd * 64; hv = 2 + hd; }
    else { const int kvh = is_meta ? hd : (hd >> 2); koff = KC_OFF + kvh * 64; hv = 10 + kvh; }
    const bf16_t* kbase = qk + koff;
    const bf16_t* vbase = vt + ((size_t)(b * NVH + hv) * 64) * VL;
    int t_lo = 0, nt = 0;
    if (type <= 1) { t_lo = 0; nt = 64; }
    else if (type == 3) { t_lo = max(0, 4 * qblk - 2); nt = min(63, 4 * qblk + 5) - t_lo + 1; }
    else if (type == 4) { t_lo = 0; nt = 2; }
    else if (type == 2) { t_lo = min(max(4 * qblk - 4, 0), 56); nt = min(max(4 * qblk - 1, 0), 56) + 7 - t_lo + 1; }
    int qrow, qhead, sq; bool wactive = true, svalid = true;
    if (!is_meta) { sq = 256 * qblk + 32 * wid + r32; qrow = b * SEQ + sq; qhead = hd; }
    else if (type == 5) { qrow = MROW0 + 16 * b + (r32 & 15); qhead = hd; sq = (r32 & 15) - 16; wactive = (wid == 0); svalid = r32 < 16; }
    else { qrow = MROW0 + 16 * b + (r32 & 15); qhead = 4 * hd + 2 * (wid >> 2) + (r32 >> 4); sq = (r32 & 15) - 16; wactive = (type == 0) || (ks == 0); }
    const int qoff = (MIXER == 0 ? QA_OFF : MIXER == 1 ? QB_OFF : QC_OFF) + qhead * 64;
    const int gr = sq >> 6, gc = sq & 63;
    const int wgr = 4 * qblk + (wid >> 1);
    const int kr0 = min(max(wgr - 4, 0), 56);
    const int cs = min(max(gc - 8, 0), 48);
    const int sw0 = 256 * qblk + 32 * wid;
    if (MIXER == 1 && type == 2) { for (int i = tid; i < 465; i += 512) rpbl[i] = rpb[hd * 465 + i] * LOG2E; }
    bf16x8 qf[4];
    { const bf16_t* qp = qk + (size_t)qrow * QKP + qoff + 8 * hh;
#pragma unroll
      for (int dc = 0; dc < 4; ++dc) qf[dc] = *(const GAS bf16x8*)(qp + 16 * dc); }
    AttState S;
    S.first = true;
    if (MIXER == 0) { S.mref = sink[qhead] * LOG2E; S.lrun = hh == 0 ? 1.f : 0.f; } else { S.mref = 0.f; S.lrun = 0.f; }
#pragma unroll
    for (int i = 0; i < 16; ++i) { S.o0[i] = 0.f; S.o1[i] = 0.f; S.negm[i] = -S.mref; }
    u32x4 kA = {0u, 0u, 0u, 0u}, vA = {0u, 0u, 0u, 0u}, kB = {0u, 0u, 0u, 0u}, vB = {0u, 0u, 0u, 0u};
    const unsigned kof = (unsigned)lane * (QKP * 2) + (unsigned)wid * 16u, vof = (unsigned)lane * (VL * 2) + (unsigned)wid * 16u;
#define ATT_PREFETCH(KR, VR, IT) do { const int it_ = (IT); \
        if (it_ < 0) { KR = *(const GAS u32x4*)(kbase + (size_t)(MROW0 + 16 * b + min(lane, 15)) * QKP + 8 * wid); \
            if (wid < 4) VR = *(const GAS u32x4*)(vbase + (size_t)lane * VL + SEQ + 8 * wid); } \
        else { const int t_ = t_lo + it_; \
            KR = *(const GAS u32x4*)(kbase + (size_t)(b * SEQ + 64 * t_ + lane) * QKP + 8 * wid); \
            VR = *(const GAS u32x4*)(vbase + (size_t)lane * VL + 64 * t_ + 8 * wid); } } while (0)
#define ATT_STASH(KR, VR, BUF) do { LAS unsigned char* kb_ = lds + LDS_KV + (BUF) * 16384; \
        *(LAS u32x4*)(kb_ + wid * 1024 + lane * 16) = KR; *(LAS u32x4*)(kb_ + 8192 + wid * 1024 + lane * 16) = VR; } while (0)
#define ATT_STEP(IT, KC, VC, KN, VN) do { const int it = (IT); const int buf = (it + 1) & 1; \
        { const int t2_ = t_lo + max(min(it + 2, nt - 1), 0);     \
          KN = *(const GAS u32x4*)((const GAS char*)kbase + (size_t)(b * SEQ + 64 * t2_) * (QKP * 2) + kof); \
          VN = *(const GAS u32x4*)((const GAS char*)vbase + (size_t)t2_ * 128 + vof); } \
        const int t = t_lo + it; \
        bool act = wactive; \
        if (it < 0) { if (type == 0) act = (ks == 0); } \
        else { if (type == 0) act = ((t & 3) == ks); \
               else if (type == 3) act = (64 * t + 63 >= sw0 - 128) && (64 * t <= sw0 + 159); \
               else if (type == 2) act = (t >= kr0) && (t < kr0 + 8); } \
        if (act) { const LAS unsigned char* kb = lds + LDS_KV + buf * 16384; \
            if (it < 0) att_tile<MIXER, true>(S, kb, qf, r32, hh, 0, 0, rpbl); \
            else if (MIXER == 0) att_tile<0, false>(S, kb, qf, r32, hh, 64 * t + 4 * hh - sq, 0, rpbl); \
            else if (MIXER == 1) att_tile<1, false>(S, kb, qf, r32, hh, 4 * hh, cs, rpbl + ((t - gr + 7) * 31 + 4 * hh - gc + 15)); \
            else att_tile<2, false>(S, kb, qf, r32, hh, 0, 0, rpbl); } \
        if (it + 1 < nt) ATT_STASH(KC, VC, buf ^ 1); \
        __syncthreads(); } while (0)
    ATT_PREFETCH(kA, vA, -1); ATT_STASH(kA, vA, 0);
    if (nt > 0) ATT_PREFETCH(kA, vA, 0);
    __syncthreads();
    for (int it0 = -1; it0 < nt; it0 += 2) {
        ATT_STEP(it0, kA, vA, kB, vB);
        if (it0 + 1 < nt) ATT_STEP(it0 + 1, kB, vB, kA, vA);
    }
#undef ATT_STEP
#undef ATT_PREFETCH
#undef ATT_STASH
    float ltot = S.lrun + shx(S.lrun, 32, lane);
    if (MIXER == 2 && type == 0) {
        LAS float* mg = (LAS float*)(lds + LDS_MRG + wid * 8448);
        if (ks != 0) {
            if (hh == 0) { mg[r32] = S.mref; mg[32 + r32] = ltot; }
#pragma unroll
            for (int i = 0; i < 16; ++i) { mg[64 + i * 64 + lane] = S.o0[i]; mg[64 + 1024 + i * 64 + lane] = S.o1[i]; }
        }
        __syncthreads();
        if (ks == 0) {
            for (int k2 = 1; k2 < 4; ++k2) {
                const LAS float* pg = (const LAS float*)(lds + LDS_MRG + (wid + k2) * 8448);
                const float m2 = pg[r32], l2 = pg[32 + r32];
                const float mn = fmaxf(S.mref, m2), a1 = __builtin_amdgcn_exp2f(S.mref - mn), a2 = __builtin_amdgcn_exp2f(m2 - mn);
                ltot = ltot * a1 + l2 * a2; S.mref = mn;
#pragma unroll
                for (int i = 0; i < 16; ++i) { S.o0[i] = S.o0[i] * a1 + pg[64 + i * 64 + lane] * a2; S.o1[i] = S.o1[i] * a1 + pg[64 + 1024 + i * 64 + lane] * a2; }
            }
        }
    }
    const bool do_store = wactive && svalid && (type != 0 || ks == 0);
    {
        const float rl = 1.f / ltot;
        bf16_t* op = obuf + (size_t)qrow * 512 + qhead * 64 + 8 * hh;
#pragma unroll
        for (int ob2 = 0; ob2 < 2; ++ob2)
#pragma unroll
            for (int gp = 0; gp < 2; ++gp) {
                const int ga = 2 * gp, gb = 2 * gp + 1;
                unsigned xa0, xa1, xb0, xb1;
                if (ob2 == 0) { xa0 = pk2(S.o0[4 * ga] * rl, S.o0[4 * ga + 1] * rl); xa1 = pk2(S.o0[4 * ga + 2] * rl, S.o0[4 * ga + 3] * rl); xb0 = pk2(S.o0[4 * gb] * rl, S.o0[4 * gb + 1] * rl); xb1 = pk2(S.o0[4 * gb + 2] * rl, S.o0[4 * gb + 3] * rl); }
                else          { xa0 = pk2(S.o1[4 * ga] * rl, S.o1[4 * ga + 1] * rl); xa1 = pk2(S.o1[4 * ga + 2] * rl, S.o1[4 * ga + 3] * rl); xb0 = pk2(S.o1[4 * gb] * rl, S.o1[4 * gb + 1] * rl); xb1 = pk2(S.o1[4 * gb + 2] * rl, S.o1[4 * gb + 3] * rl); }
                const auto r0 = __builtin_amdgcn_permlane32_swap(xa0, xb0, false, false);
                const auto r1 = __builtin_amdgcn_permlane32_swap(xa1, xb1, false, false);
                if (do_store) *(u32x4*)(op + 32 * ob2 + 16 * gp) = (u32x4){r0[0], r1[0], r0[1], r1[1]};
            }
    }
    __syncthreads();
}

struct MetaChain { const bf16_t* gates; bf16_t* mixmeta; const bf16_t* Wmb; const bf16_t* Wmo; bf16_t* hb; float* ssq; unsigned* cntA; unsigned* cntB;
                   const float* fi_w; const float* fi_gain; bf16_t* fi_dst; const float* fo_w[3]; bf16_t* fo_dst[3]; int nfo; };
__device__ __forceinline__ void attn_phase(LAS unsigned char* lds, const bf16_t* qk, const bf16_t* vt, bf16_t* oa, bf16_t* ob, bf16_t* oc,
                                           const float* sink, const float* rpb, unsigned* ctr, const MetaChain& M) {
    { int c = blockIdx.x; asm volatile("" : "+s"(c));
      if (c < 48) {
        if (c < 8) attn_unit<2>(lds, 0, c >> 1, c & 1, 0, qk, vt, oc, sink, rpb);
        else if (c < 16) attn_unit<0>(lds, 4, (c - 8) >> 1, (c - 8) & 1, 0, qk, vt, oa, sink, rpb);
        else attn_unit<1>(lds, 5, (c - 16) >> 3, (c - 16) & 7, 0, qk, vt, ob, sink, rpb);
        meta_publish(M.cntA);
        if (c < 16) {
            meta_wait(M.cntA, 48u);
            const bf16_t* mixbase = M.mixmeta - (size_t)MROW0 * DM;
            { EpiBranch EB{M.gates, (bf16_t*)mixbase};
              for (int b = 0; b < 3; ++b) meta_job<EpiBranch, true>(lds, b == 0 ? oa : b == 1 ? ob : oc, M.Wmb + (size_t)b * DM * 512, 512, c >> 2, c & 3, EB, b); }
            meta_publish(M.cntB);
            meta_wait(M.cntB, 16u);
            { EpiResid ER{M.hb, M.ssq, 1.0f}; meta_job<EpiResid>(lds, mixbase, M.Wmo, DM, c >> 2, c & 3, ER); }
        }
      } else {
        const int tidl = ltid(), lane = tidl & 63, wave = __builtin_amdgcn_readfirstlane(tidl >> 6), G = gridDim.x, sgw = (c - 48) * 8 + wave, SNGW = (G - 48) * 8;
        LAS float* scr = (LAS float*)(lds + wave * 8448);
        conv_matrix(M.fi_w, DM, 2 * DFF, 2 * DFF, 1, M.fi_dst, M.fi_gain, scr, sgw, SNGW, lane);
        for (int k = 0; k < M.nfo; ++k) conv_matrix(k == 0 ? M.fo_w[0] : k == 1 ? M.fo_w[1] : M.fo_w[2], DFF, DM, DM, 0, k == 0 ? M.fo_dst[0] : k == 1 ? M.fo_dst[1] : M.fo_dst[2], nullptr, scr, sgw, SNGW, lane);
      } }
    volatile LAS int* ctlw = (volatile LAS int*)(lds + LDS_CTLW);
    const bool t0 = (ltid() == 0);
    int mine = 0;
    if (t0) mine = (int)atomicAdd(ctr, 1u);
    for (;;) {
        if (t0) ctlw[0] = mine;
        __syncthreads();
        const int u = __builtin_amdgcn_readfirstlane(ctlw[0]);
        __syncthreads();
        if (u >= ATT_NUNITS) break;
        if (t0) mine = (int)atomicAdd(ctr, 1u);
        const int v = u & 511, b = v >> 7, hd = (v >> 4) & 7, qblk = v & 15;
        if (u < 512) attn_unit<2>(lds, 1, b, hd, qblk, qk, vt, oc, sink, rpb);
        else if (u < 1024) attn_unit<1>(lds, 2, b, hd, qblk, qk, vt, ob, sink, rpb);
        else attn_unit<0>(lds, 3, b, hd, qblk, qk, vt, oa, sink, rpb);
    }
}


#define XB_TMO      128
#define XB_XCNT(j)  (256  + 64 * (j))
#define XB_XSUB(j)  (1280 + 64 * (j))
#define XB_XGEN(j)  (2304 + 64 * (j))
#define XB_TOP      3328
#define XB_TOPGEN   3392
#define XB_SPIN_CAP (1u << 18)
__device__ __forceinline__ unsigned xb_xcc_id() { return (unsigned)__builtin_amdgcn_s_getreg((3 << 11) | 20) & 0xFu; }
#define XB_SPIN(cond, bar) do { unsigned _sp = 0; while (cond) { __builtin_amdgcn_s_sleep(1); \
    if ((++_sp & 255u) == 0u) { if (xb_ld(&(bar)[XB_TMO])) break; if (_sp > XB_SPIN_CAP) { atomicAdd(&(bar)[XB_TMO], 1u); break; } } } } while (0)
struct XcdBarrier { unsigned* bar; unsigned x; volatile LAS unsigned* st; };
__device__ __forceinline__ XcdBarrier xcd_barrier_post(unsigned* bar, volatile LAS unsigned* st) {
    XcdBarrier b; b.bar = bar; b.x = xb_xcc_id(); b.st = st;
    if (threadIdx.x == 0) (void)xb_add(&bar[XB_XCNT(b.x)], 1u);
    return b;
}
__device__ __forceinline__ void xcd_barrier_complete(unsigned* bar, unsigned x, unsigned& nloc, unsigned& nx) {
    const unsigned G = gridDim.x * gridDim.y * gridDim.z;
    unsigned sum, cnt, mine, sp = 0u;
    for (;;) {
        sum = 0u; cnt = 0u; mine = 0u;
#pragma unroll
        for (unsigned j = 0; j < 16; ++j) { const unsigned c = xb_ld(&bar[XB_XCNT(j)]); sum += c; cnt += (c > 0u) ? 1u : 0u; mine = (j == x) ? c : mine; }
        if (sum == G) break;
        __builtin_amdgcn_s_sleep(1);
        if ((++sp & 255u) == 0u) { if (xb_ld(&bar[XB_TMO])) break; if (sp > XB_SPIN_CAP) { atomicAdd(&bar[XB_TMO], 1u); break; } }
    }
    nloc = mine > 0u ? mine : 1u; nx = cnt > 0u ? cnt : 1u;
}
__device__ __forceinline__ void xcd_barrier(const XcdBarrier& b) {
    asm volatile("s_waitcnt vmcnt(0)" ::: "memory");
    __syncthreads();
    if (threadIdx.x == 0) {
        unsigned* bar = b.bar; asm volatile("" : "+s"(bar)); unsigned bx = b.x; asm volatile("" : "+s"(bx));
        __builtin_amdgcn_s_waitcnt(0);
        unsigned nloc = b.st[0], nx = b.st[1];
        if (nloc == 0u) { xcd_barrier_complete(bar, bx, nloc, nx); b.st[0] = nloc; b.st[1] = nx; }
        const unsigned old = xb_add(&bar[XB_XSUB(bx)], 1u);
        const unsigned gen = old / nloc;
        if (old + 1u == (gen + 1u) * nloc) {
            __builtin_amdgcn_fence(__ATOMIC_RELEASE, "agent");
            asm volatile("s_waitcnt vmcnt(0)" ::: "memory");
            const unsigned og = xb_add(&bar[XB_TOP], 1u);
            const unsigned tg = og / nx;
            if (og + 1u == (tg + 1u) * nx) xb_add(&bar[XB_TOPGEN], 1u);
            else XB_SPIN(xb_ld(&bar[XB_TOPGEN]) == tg, bar);
            __builtin_amdgcn_fence(__ATOMIC_ACQUIRE, "agent");
            xb_add(&bar[XB_XGEN(bx)], 1u);
            asm volatile("s_waitcnt vmcnt(0)" ::: "memory");
        } else {
            XB_SPIN(xb_ld(&bar[XB_XGEN(bx)]) == gen, bar);
            __builtin_amdgcn_fence(__ATOMIC_ACQUIRE, "agent");
            asm volatile("s_waitcnt vmcnt(0)" ::: "memory");
        }
    }
    __syncthreads();
}

__device__ __forceinline__ unsigned char* lws(unsigned char* p) { asm volatile("" : "+s"(p)); return p; }
#define WSP(T, off) ((T*)(lws(P.ws) + (off)))
#define P_HMETA WSP(float, WS_HMETA)
#define P_SSQ(i) WSP(float, WS_SSQ)
#define P_TAB   WSP(float, WS_TAB)
#define P_NBUF  WSP(bf16_t, WS_N)
#define P_ACT   WSP(bf16_t, WS_X)
#define P_QK    WSP(bf16_t, WS_X)
#define P_MIXED WSP(bf16_t, WS_X)
#define P_OC    WSP(bf16_t, WS_X + (size_t)NROWS * QKP * 2)
#define P_OA    ((bf16_t*)lws((unsigned char*)P.out))
#define P_OB    ((bf16_t*)lws((unsigned char*)P.out) + (size_t)NROWS * 512)
#define P_GATES WSP(bf16_t, WS_G)
#define P_VT    WSP(bf16_t, WS_V)
#define P_WFO(k) WSP(bf16_t, WS_W + W_FO + (size_t)(k) * 5767168)
#define P_WFI(k) WSP(bf16_t, WS_W + ((k) ? W_FIB : W_FIA))
#define P_WMI    WSP(bf16_t, WS_W + W_MI)
#define P_WMB    WSP(bf16_t, WS_W + W_MB)
#define P_WMO    WSP(bf16_t, WS_W + W_MO)

__global__ void __launch_bounds__(512, 2) fwd_megakernel(Params P) {
    extern __shared__ __attribute__((aligned(16))) unsigned char lds_raw[];
    cg::grid_group grid = cg::this_grid();
    LAS unsigned char* lds = (LAS unsigned char*)lds_raw;
    volatile LAS unsigned* bst = (volatile LAS unsigned*)(lds + LDS_CTLW + 16);
    if (threadIdx.x < 2) bst[threadIdx.x] = 0u;
    __syncthreads();
    const XcdBarrier xbar = xcd_barrier_post((unsigned*)(P.ws + WS_BAR), bst);
#define GSYNC() xcd_barrier(xbar)
#define WAVE_IDS const int tidl = ltid(), lane = tidl & 63, wave = __builtin_amdgcn_readfirstlane(tidl >> 6), G = gridDim.x, gw = blockIdx.x * 8 + wave, NGW = G * 8; LAS float* scr = (LAS float*)(lds + wave * 8448)
#define CONV_MIX_BO(WB, WO)   do { WAVE_IDS; for (int b_ = 0; b_ < 3; ++b_) conv_matrix((WB) + (size_t)b_ * 512 * DM, 512, DM, DM, 0, P_WMB + (size_t)b_ * DM * 512, nullptr, scr, gw, NGW, lane); \
                                   conv_matrix((WO), DM, DM, DM, 0, P_WMO, nullptr, scr, gw, NGW, lane); __syncthreads(); } while (0)
#define SLACK_IDS WAVE_IDS; const int rem_ = (64 * 22) % G, first_ = rem_ ? rem_ : 0, nsl_ = G - first_ - 16, sgw = ((int)blockIdx.x - first_ - 16) * 8 + wave, SNGW = nsl_ * 8; \
    const bool slack = (int)blockIdx.x >= first_ + 16, mconsumer = (int)blockIdx.x >= first_ && (int)blockIdx.x < first_ + 16; const int mq = (int)blockIdx.x - first_; (void)gw; (void)NGW
#define META_FFN_OUT(k, ssqi, CNT) do { if (mconsumer) { meta_wait((CNT), 88u); EpiResid E_{P_NBUF, P_SSQ(ssqi), 0.5f}; meta_job<EpiResid>(lds, P_ACT, P_WFO(k), DFF, mq >> 2, mq & 3, E_); } } while (0)

    {
        WAVE_IDS;
        const int gt = blockIdx.x * 512 + tidl, NGT = G * 512;
        float* tab = P_TAB; bf16_t* vt = P_VT; float* ssq = P_SSQ(0);
        for (int i = gt; i < 4112 * 32; i += NGT) { const int p = i >> 5, f = i & 31; const float inv = powf(10000.f, -(float)(2 * f) / 64.f); const float a = (float)p * inv; tab[i] = cosf(a); tab[4112 * 32 + i] = sinf(a); }
        float* axr_c = tab + 2 * 4112 * 32; float* axr_s = axr_c + 65 * 16; float* axc_c = axr_s + 65 * 16; float* axc_s = axc_c + 64 * 16;
        for (int i = gt; i < 65 * 16; i += NGT) { const int r = (i >> 4) - 1, f = i & 15; const float inv = powf(10000.f, -(float)(2 * f) / 32.f); const float a = (float)r * inv; axr_c[i] = cosf(a); axr_s[i] = sinf(a); }
        for (int i = gt; i < 64 * 16; i += NGT) { const int c = i >> 4, f = i & 15; const float inv = powf(10000.f, -(float)(2 * f) / 32.f); const float a = (float)c * inv; axc_c[i] = cosf(a); axc_s[i] = sinf(a); }
        for (int i = gt; i < NB * NVH * 64 * 16; i += NGT) { const int rowi = i >> 4, sl = i & 15; vt[(size_t)rowi * VL + SEQ + 16 + sl] = 0; }
        conv_matrix(P.ffn1_w_in, DM, 2 * DFF, 2 * DFF, 1, P_WFI(0), P.ffn1_norm, scr, gw, NGW, lane);
        conv_matrix(P.ffn1_w_out, DFF, DM, DM, 0, P_WFO(0), nullptr, scr, gw, NGW, lane);
        init_rows(P, P_NBUF, ssq, gw, NGW, lane);
    }
    GSYNC();

    for (int l = 0; l < DEPTH; ++l) {
        { const int pm0 = first_panel(2 * DFF); fill_rstd(lds, P_SSQ(3 * l), pm0); EpiSwiglu E{P_ACT, P_SSQ(3 * l), (const LAS float*)(lds + LDS_RSTD), pm0}; run_gemm<EpiSwiglu, true>(lds, P_NBUF, P_WFI(0), 2 * DFF, DM, E, WSP(unsigned, WS_CTL) + 256 + 64 * (2 * l)); }
        { SLACK_IDS; META_FFN_OUT(2 * l, 3 * l + 1, WSP(unsigned, WS_CTL) + 256 + 64 * (2 * l)); if (slack) {
            conv_matrix(P.w_in + (size_t)l * DM * NIN, DM, NIN, NIN, 2, P_WMI, P.mix_norm + l * DM, scr, sgw, SNGW, lane); } }
        GSYNC();
        { EpiResid E{P_NBUF, P_SSQ(3 * l + 1), 0.5f}; run_gemm<EpiResid, true, false>(lds, P_ACT, P_WFO(2 * l), DM, DFF, E); }
        GSYNC();
        CONV_MIX_BO(P.w_branch + (size_t)l * 3 * 512 * DM, P.w_out + (size_t)l * DM * DM);
        { const int pm0 = first_panel(NIN); fill_rstd(lds, P_SSQ(3 * l + 1), pm0); EpiWin E{P_QK, P_VT, P_GATES, P_TAB, P.qn + l * 64, P.kn + l * 64, P_SSQ(3 * l + 1), (const LAS float*)(lds + LDS_RSTD), pm0}; run_gemm<EpiWin, true>(lds, P_NBUF, P_WMI, NIN, DM, E); }
        GSYNC();
        { MetaChain MC{P_GATES, WSP(bf16_t, WS_HMETA), P_WMB, P_WMO, P_NBUF, P_SSQ(3 * l + 2), WSP(unsigned, WS_CTL) + 512 + 64 * (2 * l), WSP(unsigned, WS_CTL) + 512 + 64 * (2 * l + 1),
                       P.ffn2_w_in + (size_t)l * DM * 2 * DFF, P.ffn2_norm + l * DM, P_WFI(1),
                       {P.ffn2_w_out, P.ffn1_w_out + (size_t)DFF * DM, P.ffn2_w_out + (size_t)DFF * DM}, {P_WFO(1), P_WFO(2), P_WFO(3)}, l == 0 ? 3 : 0};
          attn_phase(lds, P_QK, P_VT, P_OA, P_OB, P_OC, P.sink + l * 8, P.rpb + l * 8 * 465, WSP(unsigned, WS_CTL) + 64 * l, MC); }
        GSYNC();
        { EpiBranch E{P_GATES, P_MIXED}; run_branch(lds, P_OA, P_OB, P_OC, P_WMB, E); }
        GSYNC();
        { EpiResid E{P_NBUF, P_SSQ(3 * l + 2), 1.0f}; run_gemm<EpiResid, true, false>(lds, P_MIXED, P_WMO, DM, DM, E); }
        GSYNC();
        { const int pm0 = first_panel(2 * DFF); fill_rstd(lds, P_SSQ(3 * l + 2), pm0); EpiSwiglu E{P_ACT, P_SSQ(3 * l + 2), (const LAS float*)(lds + LDS_RSTD), pm0}; run_gemm<EpiSwiglu, true>(lds, P_NBUF, P_WFI(1), 2 * DFF, DM, E, WSP(unsigned, WS_CTL) + 256 + 64 * (2 * l + 1)); }
        { SLACK_IDS; (void)sgw; (void)SNGW; (void)slack; META_FFN_OUT(2 * l + 1, 3 * l + 3, WSP(unsigned, WS_CTL) + 256 + 64 * (2 * l + 1)); }
        if (l + 1 < DEPTH) { SLACK_IDS; (void)mconsumer; (void)mq; if (slack)
            conv_matrix(P.ffn1_w_in + (size_t)(l + 1) * DM * 2 * DFF, DM, 2 * DFF, 2 * DFF, 1, P_WFI(0), P.ffn1_norm + (l + 1) * DM, scr, sgw, SNGW, lane); }
        GSYNC();
        { EpiResid E{P_NBUF, P_SSQ(3 * l + 3), 0.5f}; run_gemm<EpiResid, true, false>(lds, P_ACT, P_WFO(2 * l + 1), DM, DFF, E); }
        GSYNC();
    }
    {
        WAVE_IDS; (void)scr;
        const float* ssq = P_SSQ(3 * DEPTH); const bf16_t* hb = P_NBUF;
        for (int r = gw; r < NREAL; r += NGW) {
            float* hp = P.out + (size_t)r * DM;
            const float rstd = row_rstd(ssq, r);
#pragma unroll
            for (int j = 0; j < 4; ++j) { const u32x2 w = *(const u32x2*)(hb + (size_t)r * DM + 4 * (lane + 64 * j)); const f32x4 g = *(const f32x4*)(P.final_norm + 4 * (lane + 64 * j));
                *(f32x4*)(hp + 4 * (lane + 64 * j)) = (f32x4){bflo(w.x) * rstd * g.x, bfhi(w.x) * rstd * g.y, bflo(w.y) * rstd * g.z, bfhi(w.y) * rstd * g.w}; }
        }
    }
    if (P.ws == nullptr) grid.sync();
}

extern "C" void kernel_launch(void* const* d_in, const int* in_sizes, int n_in, void* d_out, int out_size, void* d_ws, size_t ws_size, hipStream_t stream) {
    static int grid_blocks = 0;
    if (grid_blocks == 0) {
        if (n_in != 17 || out_size != NREAL * DM || ws_size < WS_END) { fprintf(stderr, "kernel_launch: unexpected shapes (n_in %d out %d ws %zu need %zu)\n", n_in, out_size, ws_size, (size_t)WS_END); grid_blocks = -1; return; }
        int dev = 0, cus = 0, per_cu = 0;
        (void)hipGetDevice(&dev);
        (void)hipDeviceGetAttribute(&cus, hipDeviceAttributeMultiprocessorCount, dev);
        if (hipFuncSetAttribute((const void*)fwd_megakernel, hipFuncAttributeMaxDynamicSharedMemorySize, LDS_BYTES) != hipSuccess) { fprintf(stderr, "kernel_launch: hipFuncSetAttribute failed\n"); grid_blocks = -1; return; }
        if (hipOccupancyMaxActiveBlocksPerMultiprocessor(&per_cu, (const void*)fwd_megakernel, 512, LDS_BYTES) != hipSuccess || per_cu < 1) { fprintf(stderr, "kernel_launch: occupancy query failed (%d)\n", per_cu); (void)hipGetLastError(); per_cu = 1; }
        grid_blocks = cus;
    }
    if (grid_blocks < 0) return;
    (void)hipMemsetAsync((char*)d_ws + WS_CTL, 0, CTL_BYTES, stream);
    Params p{};
    p.x = (const float*)d_in[0]; p.meta = (const float*)d_in[1]; p.ffn1_norm = (const float*)d_in[2]; p.ffn1_w_in = (const float*)d_in[3]; p.ffn1_w_out = (const float*)d_in[4];
    p.mix_norm = (const float*)d_in[5]; p.w_in = (const float*)d_in[6]; p.sink = (const float*)d_in[7]; p.rpb = (const float*)d_in[8]; p.qn = (const float*)d_in[9]; p.kn = (const float*)d_in[10];
    p.w_branch = (const float*)d_in[11]; p.w_out = (const float*)d_in[12]; p.ffn2_norm = (const float*)d_in[13]; p.ffn2_w_in = (const float*)d_in[14]; p.ffn2_w_out = (const float*)d_in[15]; p.final_norm = (const float*)d_in[16];
    p.out = (float*)d_out; p.ws = (unsigned char*)d_ws;
    void* args[] = {&p};
    hipError_t e = hipLaunchCooperativeKernel((const void*)fwd_megakernel, dim3(grid_blocks), dim3(512), args, LDS_BYTES, stream);
    if (e != hipSuccess) fprintf(stderr, "cooperative launch failed: %s (grid %d)\n", hipGetErrorString(e), grid_blocks);
}
```
